# Optimizing an MI355X kernel written in HIP

```python
import math
import jax, jax.numpy as jnp
from jax import lax
import numpy as np

D_MODEL = 1024
BATCH = 8
SEQ = 2048
DEPTH = 4

CTX_LEN = 256
GRID_W = 64
EPS = 1e-6
NEG = -1e30
F32 = jnp.float32
N_MOD = 9

D_FF = 2816

D_RNN = 512
RNN_BLOCKS = 8
RNN_BLOCK = D_RNN // RNN_BLOCKS
CONV_W = 4
CONV_LEFT = 2
LRU_C = 8.0

ML_HEADS = 4
ML_DH = 128
ML_W = ML_HEADS * ML_DH
ML_CHUNK = 128

AT_HEADS = 8
AT_KV = 2
AT_DH = 64
AT_W = AT_HEADS * AT_DH
AT_KVW = AT_KV * AT_DH
WINDOW = 128
ATT_BLOCK = 128
ROPE_BASE = 10000.0

N_BRANCH = 3
BRANCH_W = 512

OFF_RG_X = 0
OFF_RG_G = OFF_RG_X + D_RNN
OFF_ML_Q = OFF_RG_G + D_RNN
OFF_ML_K = OFF_ML_Q + ML_W
OFF_ML_V = OFF_ML_K + ML_W
OFF_ML_O = OFF_ML_V + ML_W
OFF_ML_G = OFF_ML_O + ML_W
OFF_AT_Q = OFF_ML_G + 4 * ML_HEADS
OFF_AT_K = OFF_AT_Q + AT_W
OFF_AT_V = OFF_AT_K + AT_KVW
OFF_BR_G = OFF_AT_V + AT_KVW
D_IN = OFF_BR_G + N_BRANCH * D_MODEL

kernel_name = 'hybrid_rglru_mlstm_swa_prefix_dit'


def rmsnorm(x, g):
    xf = x.astype(F32)
    y = xf * lax.rsqrt(jnp.mean(xf * xf, axis=-1, keepdims=True) + EPS)
    return (y * g.astype(F32)).astype(x.dtype)


def ln_mod(x, g, shift, scale):
    return rmsnorm(x, g) * (1 + scale) + shift


def swiglu(h, w1, w3, w2):
    return (jax.nn.silu(h @ w1) * (h @ w3)) @ w2


def axial_angles(L):
    rows = L // GRID_W
    row = jnp.repeat(jnp.arange(rows), GRID_W).astype(F32)
    col = jnp.broadcast_to(jnp.arange(GRID_W), (rows, GRID_W)).reshape(-1).astype(F32)
    half = AT_DH // 2
    inv = ROPE_BASE ** (-jnp.arange(0, half, 2, dtype=F32) / half)
    ar = row[:, None] * inv
    ac = col[:, None] * inv
    ang = jnp.concatenate([ar, ar, ac, ac], axis=-1)
    return jnp.cos(ang), jnp.sin(ang)


def rotate_axial(x):
    a1, a2, b1, b2 = jnp.split(x, 4, axis=-1)
    return jnp.concatenate([-a2, a1, -b2, b1], axis=-1)


def apply_rope(x, cos, sin):
    return x * cos[:, None, :] + rotate_axial(x) * sin[:, None, :]


def dwconv(x, w, b):
    L = x.shape[1]
    xp = jnp.pad(x, ((0, 0), (CONV_LEFT, CONV_W - 1 - CONV_LEFT), (0, 0)))
    out = b
    for k in range(CONV_W):
        out = out + xp[:, k:k + L] * w[k]
    return out


def rglru_coeffs(u, wa, ba, wi, bi, lam):
    B, L, _ = u.shape
    ub = u.reshape(B, L, RNN_BLOCKS, RNN_BLOCK)
    r = jax.nn.sigmoid(jnp.einsum('blni,nij->blnj', ub, wa.astype(F32)).reshape(B, L, D_RNN) + ba.astype(F32))
    i = jax.nn.sigmoid(jnp.einsum('blni,nij->blnj', ub, wi.astype(F32)).reshape(B, L, D_RNN) + bi.astype(F32))
    log_a = -LRU_C * jax.nn.softplus(-lam.astype(F32)) * r
    a = jnp.exp(log_a)
    b = jnp.sqrt(-jnp.expm1(2.0 * log_a)) * (i * u)
    return a, b


def linear_scan(a, b, h0):
    b = b.at[:, 0].add(a[:, 0] * h0)
    def comb(lft, rgt):
        return lft[0] * rgt[0], rgt[0] * lft[1] + rgt[1]
    _, h = lax.associative_scan(comb, (a, b), axis=1)
    return h


def rglru_branch(pl, pc, conv_w, conv_b, wa, ba, wi, bi, lam, ctx_out):
    ul = dwconv(pl[..., OFF_RG_X:OFF_RG_G], conv_w, conv_b).astype(F32)
    uc = dwconv(pc[..., OFF_RG_X:OFF_RG_G], conv_w, conv_b).astype(F32)
    hl = 0.0
    hc = 0.0
    for d in range(2):
        al, bl = rglru_coeffs(ul, wa[d], ba[d], wi[d], bi[d], lam[d])
        ac, bc = rglru_coeffs(uc, wa[d], ba[d], wi[d], bi[d], lam[d])
        if d == 1:
            al, bl, ac, bc = (jnp.flip(z, axis=1) for z in (al, bl, ac, bc))
        h_c = linear_scan(ac, bc, jnp.zeros_like(ac[:, 0]))
        h_l = linear_scan(al, bl, h_c[:, -1])
        if d == 1:
            h_l, h_c = jnp.flip(h_l, axis=1), jnp.flip(h_c, axis=1)
        hl = hl + h_l
        hc = hc + h_c
    yl = (hl * jax.nn.gelu(pl[..., OFF_RG_G:OFF_ML_Q].astype(F32))).astype(pl.dtype)
    yc = (hc * jax.nn.gelu(pc[..., OFF_RG_G:OFF_ML_Q].astype(F32))).astype(pc.dtype) if ctx_out else None
    return yl, yc


def mlstm_scan(q, k, v, li, lf, state, with_out):
    B, H, T, Dh = q.shape
    nc = T // ML_CHUNK
    def chunks(z):
        return jnp.moveaxis(z.reshape(B, H, nc, ML_CHUNK, *z.shape[3:]), 2, 0)
    causal = jnp.tril(jnp.ones((ML_CHUNK, ML_CHUNK), dtype=bool))
    def step(carry, inp):
        C, n, m = carry
        qc, kc, vc, ic, fc = inp
        b = jnp.cumsum(fc, axis=-1)
        b_end = b[..., -1]
        w_end = b_end[..., None] - b + ic
        m_new = jnp.maximum(b_end + m, jnp.max(w_end, axis=-1))
        carry_decay = jnp.exp(b_end + m - m_new)
        w = jnp.exp(w_end - m_new[..., None])
        C_new = carry_decay[..., None, None] * C + jnp.einsum('bhs,bhsk,bhsv->bhkv', w, kc, vc)
        n_new = carry_decay[..., None] * n + jnp.einsum('bhs,bhsk->bhk', w, kc)
        if not with_out:
            return (C_new, n_new, m_new), None
        log_d = jnp.where(causal, b[..., :, None] - b[..., None, :] + ic[..., None, :], NEG)
        inter = b + m[..., None]
        m_t = jnp.maximum(inter, jnp.max(log_d, axis=-1))
        s = jnp.einsum('bhtd,bhsd->bhts', qc, kc) * jnp.exp(log_d - m_t[..., None])
        dec = jnp.exp(inter - m_t)
        num = jnp.einsum('bhts,bhsv->bhtv', s, vc) + dec[..., None] * jnp.einsum('bhtk,bhkv->bhtv', qc, C)
        den = jnp.sum(s, axis=-1) + dec * jnp.einsum('bhtk,bhk->bht', qc, n)
        h = num / jnp.maximum(jnp.abs(den), jnp.exp(-m_t))[..., None]
        return (C_new, n_new, m_new), h
    state, ys = lax.scan(step, state, (chunks(q), chunks(k), chunks(v), chunks(li), chunks(lf)))
    if not with_out:
        return state, None
    return state, jnp.moveaxis(ys, 0, 2).reshape(B, H, T, Dh)


def heads(z, h, d):
    return jnp.swapaxes(z.reshape(z.shape[0], z.shape[1], h, d), 1, 2)


def mlstm_branch(pl, pc, gate_b, norm_g, ctx_out):
    B = pl.shape[0]
    def prep(p):
        q = heads(p[..., OFF_ML_Q:OFF_ML_K], ML_HEADS, ML_DH).astype(F32)
        k = heads(p[..., OFF_ML_K:OFF_ML_V], ML_HEADS, ML_DH).astype(F32) * (ML_DH ** -0.5)
        v = heads(p[..., OFF_ML_V:OFF_ML_O], ML_HEADS, ML_DH).astype(F32)
        g = p[..., OFF_ML_G:OFF_AT_Q].astype(F32) + gate_b.astype(F32)
        g = jnp.moveaxis(g.reshape(p.shape[0], p.shape[1], 4, ML_HEADS), 1, -1)
        return q, k, v, g
    ql, kl, vl, gl = prep(pl)
    qc, kc, vc, gc = prep(pc)
    zero = (jnp.zeros((B, ML_HEADS, ML_DH, ML_DH), F32), jnp.zeros((B, ML_HEADS, ML_DH), F32),
            jnp.zeros((B, ML_HEADS), F32))
    hl = 0.0
    hc = 0.0
    for d in range(2):
        seq_l = (ql, kl, vl, gl[:, 2 * d], jax.nn.log_sigmoid(gl[:, 2 * d + 1]))
        seq_c = (qc, kc, vc, gc[:, 2 * d], jax.nn.log_sigmoid(gc[:, 2 * d + 1]))
        if d == 1:
            seq_l = tuple(jnp.flip(z, axis=2) for z in seq_l)
            seq_c = tuple(jnp.flip(z, axis=2) for z in seq_c)
        st, out_c = mlstm_scan(*seq_c, zero, ctx_out)
        _, out_l = mlstm_scan(*seq_l, st, True)
        if d == 1:
            out_l = jnp.flip(out_l, axis=2)
            out_c = jnp.flip(out_c, axis=2) if ctx_out else None
        hl = hl + out_l
        if ctx_out:
            hc = hc + out_c
    def finish(h, p):
        h = h * lax.rsqrt(jnp.mean(h * h, axis=-1, keepdims=True) + EPS)
        h = jnp.swapaxes(h, 1, 2).reshape(B, -1, ML_W) * norm_g.astype(F32)
        return (h * jax.nn.sigmoid(p[..., OFF_ML_O:OFF_ML_G].astype(F32))).astype(p.dtype)
    yl = finish(hl, pl)
    yc = finish(hc, pc) if ctx_out else None
    return yl, yc


def attention_branch(pl, pc, qn_g, kn_g, sink, cos, sin, ctx_out):
    B, L, _ = pl.shape
    Lc = pc.shape[1]
    G = AT_HEADS // AT_KV
    nb = L // ATT_BLOCK
    nk = 3 * ATT_BLOCK
    scale = AT_DH ** -0.5
    def qkv(p):
        q = rmsnorm(p[..., OFF_AT_Q:OFF_AT_K].reshape(B, -1, AT_HEADS, AT_DH), qn_g).astype(F32)
        k = rmsnorm(p[..., OFF_AT_K:OFF_AT_V].reshape(B, -1, AT_KV, AT_DH), kn_g).astype(F32)
        v = p[..., OFF_AT_V:OFF_BR_G].reshape(B, -1, AT_KV, AT_DH).astype(F32)
        return q, k, v
    ql, kl, vl = qkv(pl)
    qc, kc, vc = qkv(pc)
    ql = apply_rope(ql, cos, sin)
    kl = apply_rope(kl, cos, sin)
    sink_hg = sink.astype(F32).reshape(AT_KV, G)
    qb = ql.reshape(B, nb, ATT_BLOCK, AT_KV, G, AT_DH) * scale
    def band(z):
        zp = jnp.pad(z, ((0, 0), (ATT_BLOCK, ATT_BLOCK), (0, 0), (0, 0)))
        zp = zp.reshape(B, nb + 2, ATT_BLOCK, AT_KV, AT_DH)
        return jnp.concatenate([zp[:, :-2], zp[:, 1:-1], zp[:, 2:]], axis=2)
    kband, vband = band(kl), band(vl)
    r = jnp.arange(nk)
    i = jnp.arange(ATT_BLOCK)
    in_win = jnp.abs(r[None, :] - ATT_BLOCK - i[:, None]) <= WINDOW
    kblk = jnp.arange(nb)[:, None] - 1 + r[None, :] // ATT_BLOCK
    in_rng = (kblk >= 0) & (kblk < nb)
    mask = in_win[None] & in_rng[:, None, :]
    s_lat = jnp.einsum('bnqhgd,bnkhd->bnhgqk', qb, kband)
    s_lat = jnp.where(mask[None, :, None, None], s_lat, NEG)
    s_ctx = jnp.einsum('bnqhgd,bchd->bnhgqc', qb, kc)
    s_snk = jnp.broadcast_to(sink_hg[None, None, :, :, None, None], s_lat.shape[:-1] + (1,))
    p = jax.nn.softmax(jnp.concatenate([s_lat, s_ctx, s_snk], axis=-1), axis=-1)
    o = (jnp.einsum('bnhgqk,bnkhd->bnqhgd', p[..., :nk], vband)
         + jnp.einsum('bnhgqc,bchd->bnqhgd', p[..., nk:nk + Lc], vc))
    yl = o.reshape(B, L, AT_W).astype(pl.dtype)
    yc = None
    if ctx_out:
        qcg = qc.reshape(B, Lc, AT_KV, G, AT_DH) * scale
        s = jnp.einsum('bqhgd,bchd->bhgqc', qcg, kc)
        s_snk_c = jnp.broadcast_to(sink_hg[None, :, :, None, None], s.shape[:-1] + (1,))
        pc_ = jax.nn.softmax(jnp.concatenate([s, s_snk_c], axis=-1), axis=-1)
        oc = jnp.einsum('bhgqc,bchd->bqhgd', pc_[..., :Lc], vc)
        yc = oc.reshape(B, Lc, AT_W).astype(pc.dtype)
    return yl, yc


def token_mixer(hl, hc, w_in, rg_conv_w, rg_conv_b, rg_wa, rg_ba, rg_wi, rg_bi, rg_lam,
                ml_gate_b, ml_norm_g, at_qn_g, at_kn_g, at_sink, w_branch, w_out, cos, sin, ctx_out):
    pl = hl @ w_in
    pc = hc @ w_in
    ya_l, ya_c = rglru_branch(pl, pc, rg_conv_w, rg_conv_b, rg_wa, rg_ba, rg_wi, rg_bi, rg_lam, ctx_out)
    yb_l, yb_c = mlstm_branch(pl, pc, ml_gate_b, ml_norm_g, ctx_out)
    yc_l, yc_c = attention_branch(pl, pc, at_qn_g, at_kn_g, at_sink, cos, sin, ctx_out)
    def merge(p, ya, yb, yc):
        g = jax.nn.sigmoid(p[..., OFF_BR_G:]).reshape(p.shape[:-1] + (N_BRANCH, D_MODEL))
        m = (g[..., 0, :] * (ya @ w_branch[0]) + g[..., 1, :] * (yb @ w_branch[1])
             + g[..., 2, :] * (yc @ w_branch[2]))
        return m @ w_out
    yl = merge(pl, ya_l, yb_l, yc_l)
    yc = merge(pc, ya_c, yb_c, yc_c) if ctx_out else None
    return yl, yc


def setup_inputs(seed: int = 0) -> dict:
    key = jax.random.key(seed)
    ks = jax.random.split(key, 32)
    def nrm(k, shape, sc):
        return jax.random.normal(k, shape, F32) * sc
    x = nrm(ks[0], (BATCH, SEQ, D_MODEL), 1.0)
    c = nrm(ks[1], (BATCH, D_MODEL), 1.0)
    ctx = nrm(ks[2], (BATCH, CTX_LEN, D_MODEL), 1.0)
    c_ctx = nrm(ks[3], (D_MODEL,), 1.0)
    ada_w = nrm(ks[4], (DEPTH, D_MODEL, N_MOD * D_MODEL), 0.5 * D_MODEL ** -0.5)
    ada_b = nrm(ks[5], (DEPTH, N_MOD * D_MODEL), 0.02)
    norm_g = 1.0 + nrm(ks[6], (DEPTH, 3, D_MODEL), 0.02)
    ffn_w1 = nrm(ks[7], (DEPTH, 2, D_MODEL, D_FF), D_MODEL ** -0.5)
    ffn_w3 = nrm(ks[8], (DEPTH, 2, D_MODEL, D_FF), D_MODEL ** -0.5)
    ffn_w2 = nrm(ks[9], (DEPTH, 2, D_FF, D_MODEL), D_FF ** -0.5)
    w_in = nrm(ks[10], (DEPTH, D_MODEL, D_IN), D_MODEL ** -0.5)
    rg_conv_w = nrm(ks[11], (DEPTH, CONV_W, D_RNN), CONV_W ** -0.5)
    rg_conv_b = nrm(ks[12], (DEPTH, D_RNN), 0.01)
    rg_wa = nrm(ks[13], (DEPTH, 2, RNN_BLOCKS, RNN_BLOCK, RNN_BLOCK), RNN_BLOCK ** -0.5)
    rg_ba = nrm(ks[14], (DEPTH, 2, D_RNN), 0.01)
    rg_wi = nrm(ks[15], (DEPTH, 2, RNN_BLOCKS, RNN_BLOCK, RNN_BLOCK), RNN_BLOCK ** -0.5)
    rg_bi = nrm(ks[16], (DEPTH, 2, D_RNN), 0.01)
    a0 = jax.random.uniform(ks[17], (DEPTH, 2, D_RNN), F32, 0.9, 0.999)
    pa = a0 ** (1.0 / LRU_C)
    rg_lam = jnp.log(pa) - jnp.log1p(-pa)
    ib = nrm(ks[18], (DEPTH, 2, 1, ML_HEADS), 0.1)
    fb = jnp.linspace(3.0, 6.0, ML_HEADS, dtype=F32) + nrm(ks[19], (DEPTH, 2, 1, ML_HEADS), 0.01)
    ml_gate_b = jnp.concatenate([ib, fb], axis=2).reshape(DEPTH, 4 * ML_HEADS)
    ml_norm_g = 1.0 + nrm(ks[20], (DEPTH, ML_W), 0.02)
    at_qn_g = 1.0 + nrm(ks[21], (DEPTH, AT_DH), 0.02)
    at_kn_g = 1.0 + nrm(ks[22], (DEPTH, AT_DH), 0.02)
    at_sink = nrm(ks[23], (DEPTH, AT_HEADS), 0.5)
    w_branch = nrm(ks[24], (DEPTH, N_BRANCH, BRANCH_W, D_MODEL), BRANCH_W ** -0.5)
    w_out = nrm(ks[25], (DEPTH, D_MODEL, D_MODEL), D_MODEL ** -0.5)
    return {'x': x, 'c': c, 'ctx': ctx, 'c_ctx': c_ctx, 'ada_w': ada_w, 'ada_b': ada_b,
            'norm_g': norm_g, 'ffn_w1': ffn_w1, 'ffn_w3': ffn_w3, 'ffn_w2': ffn_w2, 'w_in': w_in,
            'rg_conv_w': rg_conv_w, 'rg_conv_b': rg_conv_b, 'rg_wa': rg_wa, 'rg_ba': rg_ba,
            'rg_wi': rg_wi, 'rg_bi': rg_bi, 'rg_lam': rg_lam, 'ml_gate_b': ml_gate_b,
            'ml_norm_g': ml_norm_g, 'at_qn_g': at_qn_g, 'at_kn_g': at_kn_g, 'at_sink': at_sink,
            'w_branch': w_branch, 'w_out': w_out}


def reference(x, c, ctx, c_ctx, ada_w, ada_b, norm_g, ffn_w1, ffn_w3, ffn_w2, w_in,
              rg_conv_w, rg_conv_b, rg_wa, rg_ba, rg_wi, rg_bi, rg_lam, ml_gate_b,
              ml_norm_g, at_qn_g, at_kn_g, at_sink, w_branch, w_out):
    B, L, _ = x.shape
    cos, sin = axial_angles(L)
    sc = jax.nn.silu(c)
    scc = jax.nn.silu(c_ctx)
    xl, xc = x, ctx
    for l in range(DEPTH):
        ctx_out = l < DEPTH - 1
        ml = (sc @ ada_w[l] + ada_b[l]).reshape(B, 1, N_MOD, D_MODEL)
        mc = (scc @ ada_w[l] + ada_b[l]).reshape(N_MOD, D_MODEL)
        xl = xl + 0.5 * ml[:, :, 2] * swiglu(ln_mod(xl, norm_g[l, 0], ml[:, :, 0], ml[:, :, 1]),
                                             ffn_w1[l, 0], ffn_w3[l, 0], ffn_w2[l, 0])
        xc = xc + 0.5 * mc[2] * swiglu(ln_mod(xc, norm_g[l, 0], mc[0], mc[1]),
                                       ffn_w1[l, 0], ffn_w3[l, 0], ffn_w2[l, 0])
        yl, yc = token_mixer(ln_mod(xl, norm_g[l, 1], ml[:, :, 3], ml[:, :, 4]),
                             ln_mod(xc, norm_g[l, 1], mc[3], mc[4]),
                             w_in[l], rg_conv_w[l], rg_conv_b[l], rg_wa[l], rg_ba[l], rg_wi[l],
                             rg_bi[l], rg_lam[l], ml_gate_b[l], ml_norm_g[l], at_qn_g[l],
                             at_kn_g[l], at_sink[l], w_branch[l], w_out[l], cos, sin, ctx_out)
        xl = xl + ml[:, :, 5] * yl
        xl = xl + 0.5 * ml[:, :, 8] * swiglu(ln_mod(xl, norm_g[l, 2], ml[:, :, 6], ml[:, :, 7]),
                                             ffn_w1[l, 1], ffn_w3[l, 1], ffn_w2[l, 1])
        if ctx_out:
            xc = xc + mc[5] * yc
            xc = xc + 0.5 * mc[8] * swiglu(ln_mod(xc, norm_g[l, 2], mc[6], mc[7]),
                                           ffn_w1[l, 1], ffn_w3[l, 1], ffn_w2[l, 1])
    return xl
```

```cpp
#include <hip/hip_runtime.h>
#include <hip/hip_cooperative_groups.h>
#include <cstdio>
#include <cstdint>
namespace cg = cooperative_groups;

typedef unsigned short bf16_t;
typedef short bf16x8 __attribute__((ext_vector_type(8)));
typedef float f32x16 __attribute__((ext_vector_type(16)));
#define DEV __device__ __forceinline__
DEV int OPQ(int v) { asm volatile("" : "+v"(v)); return v; }
DEV int TID() { int t = threadIdx.x; asm volatile("" : "+v"(t)); return t; }

constexpr int D = 1024, NB = 8, SEQ = 2048, CTX = 256, DEPTH = 4, DFF = 2816;
constexpr int NLAT = NB * SEQ, NTOK = NLAT + NB * CTX;
constexpr int DIN = 6928, PW = 6912, NIN = 7040;
constexpr int NMODC = 9 * D;
constexpr int C_RGX = 0, C_RGG = 512, C_MLQ = 1024, C_MLK = 1536, C_MLV = 2048, C_MLO = 2560, C_ATQ = 3072, C_ATK = 3584, C_ATV = 3712, C_BRG = 3840;
constexpr float EPS = 1e-6f;

constexpr size_t al256(size_t x) { return (x + 255) & ~(size_t)255; }
constexpr size_t WS_X = 0;
constexpr size_t WS_XN = WS_X + al256((size_t)NTOK * D * 4);
constexpr size_t WS_U = WS_XN + al256((size_t)NTOK * D * 2);
constexpr size_t WS_P = WS_U + al256((size_t)NTOK * DFF * 2);
constexpr size_t WS_G = WS_P + al256((size_t)NTOK * PW * 2);
constexpr size_t NW13 = (size_t)2 * 5632 * 1024, NW2 = (size_t)2 * 1024 * 2816, NWIN = (size_t)NIN * 1024, NWB = (size_t)3 * 1024 * 512, NWO = (size_t)1024 * 1024;
constexpr size_t WS_W = WS_G + al256((size_t)NTOK * 16 * 4);
constexpr size_t WS_Y = WS_W + al256((NW13 + NW2 + NWIN + NWB + NWO) * 2);
constexpr size_t WS_CIN = WS_Y + al256((size_t)3 * NTOK * 512 * 2);
constexpr size_t WS_MOD = WS_CIN + al256((size_t)64 * 18 * 16384 * 2);
constexpr size_t WS_DN = WS_MOD + al256((size_t)DEPTH * NMODC * 9 * 4);
constexpr size_t WS_MLS = WS_DN + al256((size_t)1152 * 128 * 4);
constexpr size_t WS_NIN = WS_MLS + al256((size_t)1152 * 2 * 4);
constexpr size_t WS_MIN = WS_NIN + al256((size_t)1152 * 128 * 4);
constexpr size_t WS_RGS = WS_MIN + al256((size_t)1152 * 4);
constexpr size_t WS_BAR = WS_RGS + al256((size_t)NB * 2 * 18 * 512 * 2 * 4);
constexpr size_t WS_END = WS_BAR + 13824;
constexpr size_t WS_DC = WS_U;
constexpr size_t WS_QA = WS_DC + al256((size_t)1152 * 16384 * 4);
constexpr size_t WS_KA = WS_QA + al256((size_t)NTOK * 512 * 2);
static_assert(WS_KA + (size_t)NTOK * 128 * 2 <= WS_P, "overlay overflow");

constexpr int LDS_BYTES = 80 * 1024;
#ifndef REP_GEMM
#define REP_GEMM 1
#endif
#ifndef REP_MIX1
#define REP_MIX1 1
#endif
#ifndef REP_MIX2
#define REP_MIX2 1
#endif
#ifndef REP_MIX3
#define REP_MIX3 1
#endif
#ifndef REP_NORM
#define REP_NORM 1
#endif
#ifndef PHMASK
#define PHMASK 0xffff
#endif
#define PH(x) if ((PHMASK) & (x))
#ifndef MIXMASK
#define MIXMASK 7
#endif
#define MX(x) if ((MIXMASK) & (x))

struct Params {
    const float *x, *c, *ctx, *c_ctx, *ada_w, *ada_b, *norm_g, *w1, *w3, *w2, *w_in, *conv_w, *conv_b, *wa, *ba, *wi, *bi, *lam,
        *gate_b, *ml_norm_g, *qn_g, *kn_g, *sink, *w_branch, *w_out;
    float* out;
    unsigned char* ws;
};

DEV float bf2f(unsigned h) { return __uint_as_float(h << 16); }
typedef float f32x2_t __attribute__((ext_vector_type(2)));
typedef __bf16 bf16x2_t __attribute__((ext_vector_type(2)));
DEV unsigned pack2(float lo, float hi) { f32x2_t v = {lo, hi}; bf16x2_t b = __builtin_convertvector(v, bf16x2_t);
#ifdef NOISY
    return __builtin_bit_cast(unsigned, b) & 0xfffefffeu; }
#else
    return __builtin_bit_cast(unsigned, b); }
#endif
DEV bf16_t f2bf(float f) { return (bf16_t)(pack2(f, 0.f) & 0xffffu); }
DEV float sigm(float x) { return __builtin_amdgcn_rcpf(1.f + __expf(-x)); }
DEV float gelu_tanh(float x) { float u = 0.7978845608028654f * (x + 0.044715f * x * x * x); return x * sigm(2.f * u); }
DEV int acc_row(int reg, int lane) { return (reg & 3) + 8 * (reg >> 2) + 4 * (lane >> 5); }
DEV int chunk_row(int b, int q) { return q < 2 ? NLAT + b * CTX + q * 128 : b * SEQ + (q - 2) * 128; }
DEV int mod_of_row(int r) { return r < NLAT ? (r >> 11) : 8; }
DEV float wave_sum(float v) {
#pragma unroll
    for (int o = 32; o > 0; o >>= 1) v += __shfl_xor(v, o);
    return v;
}
DEV float wave_scan_add(float v, int lane) {
#pragma unroll
    for (int o = 1; o < 64; o <<= 1) { const float t = __shfl_up(v, o); if (lane >= o) v += t; }
    return v;
}
DEV float wave_scan_max(float v, int lane) {
#pragma unroll
    for (int o = 1; o < 64; o <<= 1) { const float t = __shfl_up(v, o); if (lane >= o) v = fmaxf(v, t); }
    return v;
}
DEV float wave_max(float v) {
#pragma unroll
    for (int o = 32; o > 0; o >>= 1) v = fmaxf(v, __shfl_xor(v, o));
    return v;
}
DEV f32x16 mfma(bf16x8 a, bf16x8 b, f32x16 c) { return __builtin_amdgcn_mfma_f32_32x32x16_bf16(a, b, c, 0, 0, 0); }

template <int NT> DEV void wave_mma_lds(f32x16 (&acc)[NT], const bf16_t* As, int sa, const bf16_t* Bs, int sb, int K, int lane) {
    const bf16_t* ap = As + (lane & 31) * sa + (lane >> 5) * 8;
    const bf16_t* bp = Bs + (lane & 31) * sb + (lane >> 5) * 8;
#pragma unroll 2
    for (int k = 0; k < K; k += 16) {
        bf16x8 a = *(const bf16x8*)(ap + k);
#pragma unroll
        for (int n = 0; n < NT; n++) { bf16x8 b = *(const bf16x8*)(bp + n * 32 * sb + k); acc[n] = mfma(a, b, acc[n]); }
    }
}
template <int NT, int KS> DEV void wave_mma_reg(f32x16 (&acc)[NT], const bf16x8 (&af)[KS], const bf16_t* Bs, int sb, int lane) {
    const bf16_t* bp = Bs + (lane & 31) * sb + (lane >> 5) * 8;
#pragma unroll
    for (int ks = 0; ks < KS; ks++) {
#pragma unroll
        for (int n = 0; n < NT; n++) { bf16x8 b = *(const bf16x8*)(bp + n * 32 * sb + ks * 16); acc[n] = mfma(af[ks], b, acc[n]); }
        __builtin_amdgcn_sched_barrier(0);
    }
}
template <int NC> DEV void load_tile(bf16_t* dst, int S, const bf16_t* src, size_t ld) {
    constexpr int CPR = NC / 8;
    for (int c = TID(); c < 128 * CPR; c += 256) { int r = c / CPR, kc = c % CPR; *(uint4*)(dst + r * S + kc * 8) = *(const uint4*)(src + (size_t)r * ld + kc * 8); }
}
template <int ND> DEV void load_tile_T(bf16_t* dst, int S, const bf16_t* src, size_t ld, const float* tokscale) {
    constexpr int DC = ND / 8;
    for (int c = TID(); c < 64 * DC; c += 256) {
        int tp = c & 63, dc = c >> 6;
        uint4 v0 = *(const uint4*)(src + (size_t)(2 * tp) * ld + dc * 8), v1 = *(const uint4*)(src + (size_t)(2 * tp + 1) * ld + dc * 8);
        unsigned w0[4] = {v0.x, v0.y, v0.z, v0.w}, w1[4] = {v1.x, v1.y, v1.z, v1.w};
        float s0 = 1.f, s1 = 1.f;
        if (tokscale) { s0 = tokscale[2 * tp]; s1 = tokscale[2 * tp + 1]; }
#pragma unroll
        for (int j = 0; j < 8; j++) {
            unsigned e0 = (w0[j >> 1] >> (16 * (j & 1))) & 0xffffu, e1 = (w1[j >> 1] >> (16 * (j & 1))) & 0xffffu;
            unsigned o;
            if (tokscale) o = pack2(bf2f(e0) * s0, bf2f(e1) * s1); else o = e0 | (e1 << 16);
            *(unsigned*)(dst + (dc * 8 + j) * S + 2 * tp) = o;
        }
    }
}

template <int ND> DEV void load_tile_TP(bf16_t* dst, int S, const bf16_t* src, size_t ld) {
    constexpr int DC = ND / 8;
    for (int c = TID(); c < 64 * DC; c += 256) {
        const int tp = c & 63, dc = c >> 6, l = tp & 31, g = tp >> 5, t0 = l + 64 * g, t1 = t0 + 32;
        uint4 v0 = *(const uint4*)(src + (size_t)t0 * ld + dc * 8), v1 = *(const uint4*)(src + (size_t)t1 * ld + dc * 8);
        unsigned w0[4] = {v0.x, v0.y, v0.z, v0.w}, w1[4] = {v1.x, v1.y, v1.z, v1.w};
#pragma unroll
        for (int j = 0; j < 8; j++) {
            unsigned e0 = (w0[j >> 1] >> (16 * (j & 1))) & 0xffffu, e1 = (w1[j >> 1] >> (16 * (j & 1))) & 0xffffu;
            *(unsigned*)(dst + (dc * 8 + j) * S + 4 * l + 2 * g) = e0 | (e1 << 16);
        }
    }
}

constexpr int GS = 72;
template <int NI> DEV void k_compute(f32x16 (&acc)[2][NI], const bf16_t* cA, const bf16_t* cB, int fa, int fb) {
    __builtin_amdgcn_s_setprio(1);
#pragma unroll
    for (int ks = 0; ks < 4; ks++) {
        bf16x8 a0 = *(const bf16x8*)(cA + fa + ks * 16), a1 = *(const bf16x8*)(cA + fa + 32 * GS + ks * 16);
#pragma unroll
        for (int ni = 0; ni < NI; ni++) {
            bf16x8 b0 = *(const bf16x8*)(cB + fb + ni * 32 * GS + ks * 16);
            acc[0][ni] = mfma(b0, a0, acc[0][ni]); acc[1][ni] = mfma(b0, a1, acc[1][ni]);
        }
    }
    __builtin_amdgcn_s_setprio(0);
}
typedef unsigned u32x4 __attribute__((ext_vector_type(4)));
struct RegSet { u32x4 a0, a1, a2, a3, b0, b1, b2, b3; };
template <int NI> DEV void rs_load(RegSet& r, const bf16_t* a, const bf16_t* b, int lda, int ldb) {
    r.a0 = *(const u32x4*)(a); r.a1 = *(const u32x4*)(a + (size_t)32 * lda); r.a2 = *(const u32x4*)(a + (size_t)64 * lda); r.a3 = *(const u32x4*)(a + (size_t)96 * lda);
    r.b0 = *(const u32x4*)(b); r.b1 = *(const u32x4*)(b + (size_t)32 * ldb);
    if (NI == 2) { r.b2 = *(const u32x4*)(b + (size_t)64 * ldb); r.b3 = *(const u32x4*)(b + (size_t)96 * ldb); }
}
template <int NI> DEV void rs_store(const RegSet& r, bf16_t* sa, bf16_t* sb) {
    *(u32x4*)(sa) = r.a0; *(u32x4*)(sa + 32 * GS) = r.a1; *(u32x4*)(sa + 64 * GS) = r.a2; *(u32x4*)(sa + 96 * GS) = r.a3;
    *(u32x4*)(sb) = r.b0; *(u32x4*)(sb + 32 * GS) = r.b1;
    if (NI == 2) { *(u32x4*)(sb + 64 * GS) = r.b2; *(u32x4*)(sb + 96 * GS) = r.b3; }
}
template <int NI, int NK = 0> DEV void gemm_kloop(f32x16 (&acc)[2][NI], const bf16_t* __restrict__ A, int lda, const bf16_t* __restrict__ B, int ldb, int K, bf16_t* lds,
                                      const bf16_t* nA, const bf16_t* nB, int nlda, int nldb, bool first, RegSet& p, RegSet& q) {
    const int tid = TID(), lane = tid & 63, wave = tid >> 6, wr = wave >> 1, wc = wave & 1;
    bf16_t* sA = lds;
    bf16_t* sB = lds + 2 * 128 * GS;
    const int lrow = tid >> 3, lkc = (tid & 7) * 8;
    const bf16_t* ga = A + (size_t)lrow * lda + lkc;
    const bf16_t* gb = B + (size_t)lrow * ldb + lkc;
    const bool hasn = nA != nullptr;
    const bf16_t* na = hasn ? nA + (size_t)lrow * nlda + lkc : ga;
    const bf16_t* nb = hasn ? nB + (size_t)lrow * nldb + lkc : gb;
    const int so = lrow * GS + lkc;
    const int nk = NK > 0 ? NK : (K >> 6);
    const int fa = (wr * 64 + (lane & 31)) * GS + (lane >> 5) * 8;
    const int fb = (wc * 32 * NI + (lane & 31)) * GS + (lane >> 5) * 8;
    if (first) {
        rs_load<NI>(p, ga, gb, lda, ldb);
        rs_store<NI>(p, sA + so, sB + so);
        rs_load<NI>(p, ga + 64, gb + 64, lda, ldb);
        rs_load<NI>(q, ga + 128, gb + 128, lda, ldb);
        __syncthreads();
    }
#pragma unroll (NK > 0 ? NK / 2 : 1)
    for (int kt = 0; kt < nk; kt += 2) {
        k_compute<NI>(acc, sA, sB, fa, fb);
        rs_store<NI>(p, sA + 128 * GS + so, sB + 128 * GS + so);
        if (kt + 3 < nk) rs_load<NI>(p, ga + (size_t)(kt + 3) * 64, gb + (size_t)(kt + 3) * 64, lda, ldb);
        else if (hasn) rs_load<NI>(p, na + (size_t)(kt + 3 - nk) * 64, nb + (size_t)(kt + 3 - nk) * 64, nlda, nldb);
        __syncthreads();
        k_compute<NI>(acc, sA + 128 * GS, sB + 128 * GS, fa, fb);
        if (kt + 2 < nk || hasn) rs_store<NI>(q, sA + so, sB + so);
        if (kt + 4 < nk) rs_load<NI>(q, ga + (size_t)(kt + 4) * 64, gb + (size_t)(kt + 4) * 64, lda, ldb);
        else if (hasn) rs_load<NI>(q, na + (size_t)(kt + 4 - nk) * 64, nb + (size_t)(kt + 4 - nk) * 64, nlda, nldb);
        __syncthreads();
    }
}
DEV void tile_of(int t, int mtiles, int ntiles, int& mt, int& nt) {
    const int nig = 32 * ntiles, gid = t / nig, fm = gid * 32, gsz = min(mtiles - fm, 32);
    mt = fm + (t % nig) % gsz; nt = (t % nig) / gsz;
}
template <int NI> DEV void zero_acc(f32x16 (&acc)[2][NI]) {
#pragma unroll
    for (int i = 0; i < 2; i++)
#pragma unroll
        for (int j = 0; j < NI; j++)
#pragma unroll
            for (int r = 0; r < 16; r++) acc[i][j][r] = 0.f;
}

DEV void wconv_job(const Params& p, int l, int job, bf16_t* lds) {
    bf16_t* W = (bf16_t*)(p.ws + WS_W);
    const int tid = TID();
    int mat, sub = 0, K, ntl;
    bf16_t* dst;
    if (job < 2816) { mat = 0; sub = job / 1408; job %= 1408; K = 1024; dst = W + (size_t)sub * 5632 * 1024; }
    else if (job < 4224) { job -= 2816; mat = 1; sub = job / 704; job %= 704; K = 2816; dst = W + NW13 + (size_t)sub * 1024 * 2816; }
    else if (job < 5984) { job -= 4224; mat = 2; K = 1024; dst = W + NW13 + NW2; }
    else if (job < 6368) { job -= 5984; mat = 3; sub = job / 128; job %= 128; K = 512; dst = W + NW13 + NW2 + NWIN + (size_t)sub * 1024 * 512; }
    else { job -= 6368; mat = 4; K = 1024; dst = W + NW13 + NW2 + NWIN + NWB; }
    const int ktl = K / 64;
    ntl = job / ktl; const int kt = job % ktl;
    const int n0 = ntl * 64, k0 = kt * 64;
    const int nn = tid & 63, np = n0 + nn;
    const float* colp = nullptr; size_t ld = 0;
    if (mat == 0) { int g = np >> 6, s = (np >> 5) & 1, j = np & 31; colp = (s ? p.w3 : p.w1) + ((size_t)(l * 2 + sub) * 1024) * DFF + g * 32 + j; ld = DFF; }
    else if (mat == 1) { colp = p.w2 + ((size_t)(l * 2 + sub) * DFF) * 1024 + np; ld = 1024; }
    else if (mat == 2) { int oc = np < 3072 ? np : (np < 6912 ? np + 16 : (np < 6928 ? np - 6912 + 3072 : -1)); if (oc >= 0) colp = p.w_in + (size_t)l * 1024 * DIN + oc; ld = DIN; }
    else if (mat == 3) { colp = p.w_branch + ((size_t)(l * 3 + sub) * 512) * 1024 + np; ld = 1024; }
    else { colp = p.w_out + (size_t)l * 1024 * 1024 + np; ld = 1024; }
    bf16_t* tl = lds;
#pragma unroll 4
    for (int it = 0; it < 8; it++) {
        const int kk = 2 * ((tid >> 6) + 4 * it);
        const float v0 = colp ? colp[(size_t)(k0 + kk) * ld] : 0.f, v1 = colp ? colp[(size_t)(k0 + kk + 1) * ld] : 0.f;
#ifdef NW
        *(unsigned*)(tl + nn * 66 + kk) = pack2(v0, v1) & 0xfffefffeu;
#else
        *(unsigned*)(tl + nn * 66 + kk) = pack2(v0, v1);
#endif
    }
    __syncthreads();
#pragma unroll
    for (int it = 0; it < 2; it++) {
        int ch = tid + 256 * it, r = ch >> 3, kc = ch & 7;
        const unsigned* s = (const unsigned*)(tl + r * 66 + kc * 8);
        uint4 v; v.x = s[0]; v.y = s[1]; v.z = s[2]; v.w = s[3];
        *(uint4*)(dst + (size_t)(n0 + r) * K + k0 + kc * 8) = v;
    }
    __syncthreads();
}
constexpr int NWJOBS = 6624;

DEV void ada_job(const Params& p, int job, float* lds) {
    const int tid = TID();
    const int l = job / 144, n0 = (job % 144) * 64;
    float* sc = lds;
    float* red = lds + 9 * 1024;
    __syncthreads();
    for (int i = tid; i < 9 * 1024; i += 256) { float v = i < 8192 ? p.c[i] : p.c_ctx[i - 8192]; sc[i] = v * sigm(v); }
    __syncthreads();
    const int cg = tid & 15, kg = tid >> 4;
    const float* w = p.ada_w + ((size_t)l * 1024 + kg * 64) * NMODC + n0 + cg * 4;
    float4 a[9];
#pragma unroll
    for (int m = 0; m < 9; m++) a[m] = make_float4(0.f, 0.f, 0.f, 0.f);
#pragma unroll 8
    for (int k = 0; k < 64; k++) {
        const float4 wv = *(const float4*)(w + (size_t)k * NMODC);
#pragma unroll
        for (int m = 0; m < 9; m++) { const float sv = sc[m * 1024 + kg * 64 + k]; a[m].x += sv * wv.x; a[m].y += sv * wv.y; a[m].z += sv * wv.z; a[m].w += sv * wv.w; }
    }
#pragma unroll
    for (int m = 0; m < 9; m++) *(float4*)(red + (kg * 9 + m) * 64 + cg * 4) = a[m];
    __syncthreads();
    float* mod = (float*)(p.ws + WS_MOD);
    for (int i = tid; i < 9 * 64; i += 256) {
        const int m = i >> 6, cc = i & 63;
        float sum = 0.f;
#pragma unroll
        for (int g = 0; g < 16; g++) sum += red[(g * 9 + m) * 64 + cc];
        mod[((size_t)l * 9 + m) * NMODC + n0 + cc] = sum + p.ada_b[(size_t)l * NMODC + n0 + cc];
    }
    __syncthreads();
}

DEV void norm_phase(const Params& p, int l, int which, int nrows) {
    const float* X = (const float*)(p.ws + WS_X);
    bf16_t* XN = (bf16_t*)(p.ws + WS_XN);
    const float* mod = (const float*)(p.ws + WS_MOD) + (size_t)l * 9 * NMODC;
    const float* g = p.norm_g + ((size_t)l * 3 + which) * D;
    const int lane = TID() & 63, gw = blockIdx.x * 4 + (TID() >> 6), nw = gridDim.x * 4;
    for (int r = gw; r < nrows; r += nw) {
        const float4* xr = (const float4*)(X + (size_t)r * D);
        float4 v[4]; float ss = 0.f;
#pragma unroll
        for (int i = 0; i < 4; i++) { v[i] = xr[lane + 64 * i]; ss += v[i].x * v[i].x + v[i].y * v[i].y + v[i].z * v[i].z + v[i].w * v[i].w; }
        ss = wave_sum(ss);
        const float rstd = rsqrtf(ss * (1.f / D) + EPS);
        const float* mrow = mod + (size_t)mod_of_row(r) * NMODC;
#pragma unroll
        for (int i = 0; i < 4; i++) {
            const int c = 4 * (lane + 64 * i);
            const float4 gg = *(const float4*)(g + c), sh = *(const float4*)(mrow + (3 * which) * D + c), sc = *(const float4*)(mrow + (3 * which + 1) * D + c);
            float y0 = v[i].x * rstd * gg.x * (1.f + sc.x) + sh.x, y1 = v[i].y * rstd * gg.y * (1.f + sc.y) + sh.y;
            float y2 = v[i].z * rstd * gg.z * (1.f + sc.z) + sh.z, y3 = v[i].w * rstd * gg.w * (1.f + sc.w) + sh.w;
            uint2 o; o.x = pack2(y0, y1); o.y = pack2(y2, y3);
#ifdef NX
            o.x &= 0xfffefffeu; o.y &= 0xfffefffeu;
#endif
            *(uint2*)(XN + (size_t)r * D + c) = o;
        }
    }
}

DEV void ffn_up_phase(const Params& p, int f, int mtiles, bf16_t* lds) {
    const bf16_t* A = (const bf16_t*)(p.ws + WS_XN);
    const bf16_t* Bt = (const bf16_t*)(p.ws + WS_W) + (size_t)f * 5632 * 1024;
    bf16_t* U = (bf16_t*)(p.ws + WS_U);
    const int tid = TID(), lane = tid & 63, wave = tid >> 6, wr = wave >> 1, wc = wave & 1;
    const int ntiles = 44, tot = mtiles * ntiles;
    RegSet rp = {}, rq = {}; bool first = true;
    for (int t = blockIdx.x; t < tot; t += gridDim.x) {
        int mt, nt; tile_of(t, mtiles, ntiles, mt, nt);
        const bool hasn = t + (int)gridDim.x < tot; int mt2 = 0, nt2 = 0; if (hasn) tile_of(t + gridDim.x, mtiles, ntiles, mt2, nt2);
        f32x16 acc[2][2]; zero_acc<2>(acc);
        gemm_kloop<2, 16>(acc, A + (size_t)mt * 128 * D, D, Bt + (size_t)nt * 128 * D, D, D, lds, hasn ? A + (size_t)mt2 * 128 * D : nullptr, hasn ? Bt + (size_t)nt2 * 128 * D : nullptr, D, D, first, rp, rq);
        first = false;
        const int hh = lane >> 5;
#pragma unroll
        for (int mi = 0; mi < 2; mi++) {
            const int row = mt * 128 + wr * 64 + mi * 32 + (lane & 31);
#pragma unroll
            for (int gp = 0; gp < 2; gp++) {
                unsigned pk[2][2];
#pragma unroll
                for (int gg = 0; gg < 2; gg++) {
                    const int g = 2 * gp + gg;
                    float u[4];
#pragma unroll
                    for (int j = 0; j < 4; j++) { const float h1 = acc[mi][0][4 * g + j], h3 = acc[mi][1][4 * g + j]; u[j] = h1 * sigm(h1) * h3; }
                    pk[gg][0] = pack2(u[0], u[1]); pk[gg][1] = pack2(u[2], u[3]);
                }
                const unsigned s0 = hh ? pk[0][0] : pk[1][0], s1 = hh ? pk[0][1] : pk[1][1];
                const unsigned r0 = (unsigned)__shfl_xor((int)s0, 32), r1 = (unsigned)__shfl_xor((int)s1, 32);
                uint4 o;
                if (hh == 0) { o.x = pk[0][0]; o.y = pk[0][1]; o.z = r0; o.w = r1; }
                else { o.x = r0; o.y = r1; o.z = pk[1][0]; o.w = pk[1][1]; }
                const int ucol = nt * 64 + wc * 32 + 16 * gp + 8 * hh;
                *(uint4*)(U + (size_t)row * DFF + ucol) = o;
            }
        }
    }
}
template <int NK> DEV void resid_gemm_phase(const Params& p, int l, const bf16_t* A, int K, const bf16_t* Bt, int gidx, float scale, int mtiles, bf16_t* lds, float* outp = nullptr) {
    float* X = (float*)(p.ws + WS_X);
    const float* mod = (const float*)(p.ws + WS_MOD) + (size_t)l * 9 * NMODC;
    const int tid = TID(), lane = tid & 63, wave = tid >> 6, wr = wave >> 1, wc = wave & 1;
    const int ntiles = 8, tot = mtiles * ntiles, G = gridDim.x;
    const int tfull = (tot / G) * G;
    {
        RegSet rp = {}, rq = {}; bool first = true;
        for (int t = blockIdx.x; t < tfull; t += G) {
            int mt, nt; tile_of(t, mtiles, ntiles, mt, nt);
            const bool hasn = t + G < tfull; int mt2 = 0, nt2 = 0; if (hasn) tile_of(t + G, mtiles, ntiles, mt2, nt2);
            f32x16 acc[2][2]; zero_acc<2>(acc);
            gemm_kloop<2, NK>(acc, A + (size_t)mt * 128 * K, K, Bt + (size_t)nt * 128 * K, K, K, lds, hasn ? A + (size_t)mt2 * 128 * K : nullptr, hasn ? Bt + (size_t)nt2 * 128 * K : nullptr, K, K, first, rp, rq);
            first = false;
            const float* mrow = mod + (size_t)mod_of_row(mt * 128) * NMODC + gidx * D;
#pragma unroll
            for (int ni = 0; ni < 2; ni++)
#pragma unroll
                for (int g = 0; g < 4; g++) {
                    const int col = nt * 128 + wc * 64 + ni * 32 + 8 * g + 4 * (lane >> 5);
                    const float4 gt = *(const float4*)(mrow + col);
#pragma unroll
                    for (int mi = 0; mi < 2; mi++) {
                        const int row = mt * 128 + wr * 64 + mi * 32 + (lane & 31);
                        float4* xp = (float4*)(X + (size_t)row * D + col);
                        float4 xv = *xp;
                        xv.x += scale * gt.x * acc[mi][ni][4 * g + 0]; xv.y += scale * gt.y * acc[mi][ni][4 * g + 1];
                        xv.z += scale * gt.z * acc[mi][ni][4 * g + 2]; xv.w += scale * gt.w * acc[mi][ni][4 * g + 3];
                        if (outp) *(float4*)(outp + (size_t)row * D + col) = xv; else *xp = xv;
                    }
                }
        }
    }
    {
        const int nhalf = 2 * (tot - tfull);
        RegSet rp = {}, rq = {};
        for (int h = blockIdx.x; h < nhalf; h += G) {
            int mt, nt; tile_of(tfull + (h >> 1), mtiles, ntiles, mt, nt);
            const int nt2 = nt * 2 + (h & 1);
            f32x16 acc[2][1]; zero_acc<1>(acc);
            gemm_kloop<1, NK>(acc, A + (size_t)mt * 128 * K, K, Bt + (size_t)nt2 * 64 * K, K, K, lds, nullptr, nullptr, K, K, true, rp, rq);
            const float* mrow = mod + (size_t)mod_of_row(mt * 128) * NMODC + gidx * D;
#pragma unroll
            for (int g = 0; g < 4; g++) {
                const int col = nt2 * 64 + wc * 32 + 8 * g + 4 * (lane >> 5);
                const float4 gt = *(const float4*)(mrow + col);
#pragma unroll
                for (int mi = 0; mi < 2; mi++) {
                    const int row = mt * 128 + wr * 64 + mi * 32 + (lane & 31);
                    float4* xp = (float4*)(X + (size_t)row * D + col);
                    float4 xv = *xp;
                    xv.x += scale * gt.x * acc[mi][0][4 * g + 0]; xv.y += scale * gt.y * acc[mi][0][4 * g + 1];
                    xv.z += scale * gt.z * acc[mi][0][4 * g + 2]; xv.w += scale * gt.w * acc[mi][0][4 * g + 3];
                    if (outp) *(float4*)(outp + (size_t)row * D + col) = xv; else *xp = xv;
                }
            }
        }
    }
}
DEV void win_tile_of(int t, bool last, int& mt, int& nt) {
    if (!last) { tile_of(t, 144, 55, mt, nt); return; }
    if (t < 128 * 55) { tile_of(t, 128, 55, mt, nt); return; }
    const int u = t - 128 * 55, k = u >> 4;
    mt = 128 + (u & 15);
    nt = k < 4 ? k : (k < 12 ? 8 + k : (k < 14 ? 16 + k : 54));
}
DEV void win_phase(const Params& p, bool last, bf16_t* lds) {
    const bf16_t* A = (const bf16_t*)(p.ws + WS_XN);
    const bf16_t* Bt = (const bf16_t*)(p.ws + WS_W) + NW13 + NW2;
    bf16_t* P = (bf16_t*)(p.ws + WS_P);
    float* G = (float*)(p.ws + WS_G);
    const int tid = TID(), lane = tid & 63, wave = tid >> 6, wr = wave >> 1, wc = wave & 1;
    const int tot = last ? 128 * 55 + 16 * 15 : 144 * 55;
    RegSet rp = {}, rq = {}; bool first = true;
    for (int t = blockIdx.x; t < tot; t += gridDim.x) {
        int mt, nt; win_tile_of(t, last, mt, nt);
        const bool hasn = t + (int)gridDim.x < tot; int mt2 = 0, nt2 = 0; if (hasn) win_tile_of(t + gridDim.x, last, mt2, nt2);
        f32x16 acc[2][2]; zero_acc<2>(acc);
        gemm_kloop<2, 16>(acc, A + (size_t)mt * 128 * D, D, Bt + (size_t)nt * 128 * D, D, D, lds, hasn ? A + (size_t)mt2 * 128 * D : nullptr, hasn ? Bt + (size_t)nt2 * 128 * D : nullptr, D, D, first, rp, rq);
        first = false;
        if (nt < 54) {
            const int hh = lane >> 5;
#pragma unroll
            for (int ni = 0; ni < 2; ni++)
#pragma unroll
                for (int mi = 0; mi < 2; mi++) {
                    const int row = mt * 128 + wr * 64 + mi * 32 + (lane & 31);
#pragma unroll
                    for (int gp = 0; gp < 2; gp++) {
                        const int g0 = 2 * gp, g1 = g0 + 1;
                        const unsigned a0 = pack2(acc[mi][ni][4 * g0], acc[mi][ni][4 * g0 + 1]), a1 = pack2(acc[mi][ni][4 * g0 + 2], acc[mi][ni][4 * g0 + 3]);
                        const unsigned b0 = pack2(acc[mi][ni][4 * g1], acc[mi][ni][4 * g1 + 1]), b1 = pack2(acc[mi][ni][4 * g1 + 2], acc[mi][ni][4 * g1 + 3]);
                        const unsigned s0 = hh ? a0 : b0, s1 = hh ? a1 : b1;
                        const unsigned r0 = (unsigned)__shfl_xor((int)s0, 32), r1 = (unsigned)__shfl_xor((int)s1, 32);
                        uint4 o;
                        if (hh == 0) { o.x = a0; o.y = a1; o.z = r0; o.w = r1; }
                        else { o.x = r0; o.y = r1; o.z = b0; o.w = b1; }
                        const int col = nt * 128 + wc * 64 + ni * 32 + 16 * gp + 8 * hh;
                        *(uint4*)(P + (size_t)row * PW + col) = o;
                    }
                }
        } else {
#pragma unroll
        for (int ni = 0; ni < 2; ni++)
#pragma unroll
            for (int g = 0; g < 4; g++) {
                const int col = nt * 128 + wc * 64 + ni * 32 + 8 * g + 4 * (lane >> 5);
#pragma unroll
                for (int mi = 0; mi < 2; mi++) {
                    const int row = mt * 128 + wr * 64 + mi * 32 + (lane & 31);
                    if (col < PW) { uint2 o; o.x = pack2(acc[mi][ni][4 * g], acc[mi][ni][4 * g + 1]); o.y = pack2(acc[mi][ni][4 * g + 2], acc[mi][ni][4 * g + 3]); *(uint2*)(P + (size_t)row * PW + col) = o; }
                    else if (col < PW + 16) *(float4*)(G + (size_t)row * 16 + (col - PW)) = make_float4(acc[mi][ni][4 * g], acc[mi][ni][4 * g + 1], acc[mi][ni][4 * g + 2], acc[mi][ni][4 * g + 3]);
                }
            }
        }
    }
}
DEV void merge_phase(const Params& p, int mtiles, bf16_t* lds) {
    const bf16_t* Y = (const bf16_t*)(p.ws + WS_Y);
    const bf16_t* Wb = (const bf16_t*)(p.ws + WS_W) + NW13 + NW2 + NWIN;
    const bf16_t* P = (const bf16_t*)(p.ws + WS_P);
    bf16_t* M = (bf16_t*)(p.ws + WS_XN);
    const int tid = TID(), lane = tid & 63, wave = tid >> 6, wr = wave >> 1, wc = wave & 1;
    const int ntiles = 16, tot = mtiles * ntiles;
    RegSet rp = {}, rq = {}; bool first = true;
    for (int t = blockIdx.x; t < tot; t += gridDim.x) {
        int mt, nt; tile_of(t, mtiles, ntiles, mt, nt);
        const bool hasn = t + (int)gridDim.x < tot; int mt2 = 0, nt2 = 0; if (hasn) tile_of(t + gridDim.x, mtiles, ntiles, mt2, nt2);
        f32x16 out[2][1]; zero_acc<1>(out);
#pragma unroll 1
        for (int j = 0; j < 3; j++) {
            f32x16 acc[2][1]; zero_acc<1>(acc);
            const int jn = j < 2 ? j + 1 : 0, mtn = j < 2 ? mt : mt2, ntn = j < 2 ? nt : nt2;
            const bool hn = j < 2 || hasn;
            gemm_kloop<1, 8>(acc, Y + (size_t)j * NTOK * 512 + (size_t)mt * 128 * 512, 512, Wb + (size_t)j * 1024 * 512 + (size_t)nt * 64 * 512, 512, 512, lds,
                          hn ? Y + (size_t)jn * NTOK * 512 + (size_t)mtn * 128 * 512 : nullptr, hn ? Wb + (size_t)jn * 1024 * 512 + (size_t)ntn * 64 * 512 : nullptr, 512, 512, first, rp, rq);
            first = false;
#pragma unroll
            for (int mi = 0; mi < 2; mi++) {
                const int row = mt * 128 + wr * 64 + mi * 32 + (lane & 31);
#pragma unroll
                for (int g = 0; g < 4; g++) {
                    const int col = nt * 64 + wc * 32 + 8 * g + 4 * (lane >> 5);
                    const uint2 gv = *(const uint2*)(P + (size_t)row * PW + C_BRG + j * 1024 + col);
                    out[mi][0][4 * g + 0] += sigm(bf2f(gv.x & 0xffffu)) * acc[mi][0][4 * g + 0];
                    out[mi][0][4 * g + 1] += sigm(bf2f(gv.x >> 16)) * acc[mi][0][4 * g + 1];
                    out[mi][0][4 * g + 2] += sigm(bf2f(gv.y & 0xffffu)) * acc[mi][0][4 * g + 2];
                    out[mi][0][4 * g + 3] += sigm(bf2f(gv.y >> 16)) * acc[mi][0][4 * g + 3];
                }
            }
        }
#pragma unroll
        for (int mi = 0; mi < 2; mi++) {
            const int row = mt * 128 + wr * 64 + mi * 32 + (lane & 31);
#pragma unroll
            for (int g = 0; g < 4; g++) {
                const int col = nt * 64 + wc * 32 + 8 * g + 4 * (lane >> 5);
                uint2 o; o.x = pack2(out[mi][0][4 * g], out[mi][0][4 * g + 1]); o.y = pack2(out[mi][0][4 * g + 2], out[mi][0][4 * g + 3]);
                *(uint2*)(M + (size_t)row * D + col) = o;
            }
        }
    }
}

DEV void attprep_job(const Params& p, int l, int job) {
    const bf16_t* P = (const bf16_t*)(p.ws + WS_P);
    bf16_t* Qa = (bf16_t*)(p.ws + WS_QA);
    bf16_t* Ka = (bf16_t*)(p.ws + WS_KA);
    const int lane = TID() & 63, wave = TID() >> 6;
    const float gq = p.qn_g[l * 64 + lane], gk = p.kn_g[l * 64 + lane];
    const float inv = exp2f(-(float)(lane & 15) * (13.287712379549449f / 16.f));
    for (int i = 0; i < 8; i++) {
        const int r = job * 32 + wave * 8 + i;
        float cs = 1.f, sn = 0.f;
        if (r < NLAT) { const int tk = r & (SEQ - 1); const float pos = (lane < 32) ? (float)(tk >> 6) : (float)(tk & 63); const float ang = pos * inv; cs = __cosf(ang); sn = __sinf(ang); }
        const float sgn = (lane & 16) ? 1.f : -1.f;
        for (int hd = 0; hd < 10; hd++) {
            const float xv = bf2f(P[(size_t)r * PW + C_ATQ + hd * 64 + lane]);
            const float ss = wave_sum(xv * xv);
            float y = xv * rsqrtf(ss * (1.f / 64.f) + EPS) * (hd < 8 ? gq : gk);
            const float yp = __shfl_xor(y, 16);
            y = y * cs + sgn * yp * sn;
#ifdef NAT
            if (hd < 8) Qa[(size_t)r * 512 + hd * 64 + lane] = f2bf(y * 0.125f) & 0xfffe;
            else Ka[(size_t)r * 128 + (hd - 8) * 64 + lane] = f2bf(y) & 0xfffe;
#else
            if (hd < 8) Qa[(size_t)r * 512 + hd * 64 + lane] = f2bf(y * 0.125f);
            else Ka[(size_t)r * 128 + (hd - 8) * 64 + lane] = f2bf(y);
#endif
        }
    }
}

DEV void att_job(const Params& p, int l, int b, int qb, int h, bf16_t* lds) {
    const bf16_t* P = (const bf16_t*)(p.ws + WS_P);
    const bf16_t* Qa = (const bf16_t*)(p.ws + WS_QA);
    const bf16_t* Ka = (const bf16_t*)(p.ws + WS_KA);
    bf16_t* Yc = (bf16_t*)(p.ws + WS_Y) + (size_t)2 * NTOK * 512;
    const int tid = TID(), lane = tid & 63, wave = tid >> 6;
    bf16_t* Ks = lds;
    bf16_t* Vt = lds + 128 * 72;
    bf16_t* Pw = Vt + 64 * 136;
    const int kvh = h >> 2;
    const int Rq = qb < 16 ? b * SEQ + qb * 128 : NLAT + b * CTX + (qb - 16) * 128;
#ifdef ATT_COPY
    for (int i = tid; i < 128 * 64; i += 256) { const int r = i >> 6, c = i & 63; Yc[(size_t)(Rq + r) * 512 + h * 64 + c] = Qa[(size_t)(Rq + r) * 512 + h * 64 + c]; }
    return;
#endif
    __syncthreads();
    load_tile<64>(Pw, 72, Qa + (size_t)Rq * 512 + h * 64, 512);
    __syncthreads();
    bf16x8 qf[4];
#pragma unroll
    for (int ks = 0; ks < 4; ks++) qf[ks] = *(const bf16x8*)(Pw + (wave * 32 + (lane & 31)) * 72 + ks * 16 + (lane >> 5) * 8);
    const float sink = p.sink[l * 8 + h];
    float mrun[16], lrun[16];
    f32x16 o[2];
#pragma unroll
    for (int r = 0; r < 16; r++) { mrun[r] = sink; lrun[r] = 0.f; o[0][r] = 0.f; o[1][r] = 0.f; }
    for (int kt = 0; kt < 5; kt++) {
        int Rk, mode = 0;
        if (kt < 3) {
            if (qb >= 16) continue;
            const int nb = qb - 1 + kt;
            if (nb < 0 || nb >= 16) continue;
            Rk = b * SEQ + nb * 128; mode = kt == 0 ? 1 : (kt == 2 ? 2 : 0);
        } else Rk = NLAT + b * CTX + (kt - 3) * 128;
        __syncthreads();
        load_tile<64>(Ks, 72, Ka + (size_t)Rk * 128 + kvh * 64, 128);
        load_tile_TP<64>(Vt, 136, P + (size_t)Rk * PW + C_ATV + kvh * 64, PW);
        __syncthreads();
        f32x16 s[4];
#pragma unroll
        for (int n = 0; n < 4; n++)
#pragma unroll
            for (int r = 0; r < 16; r++) s[n][r] = 0.f;
        wave_mma_reg<4, 4>(s, qf, Ks, 72, lane);
#pragma unroll
        for (int r = 0; r < 16; r++) {
            const int qi = wave * 32 + acc_row(r, lane);
            float mx = -3.0e38f;
#pragma unroll
            for (int n = 0; n < 4; n++) {
                const int ki = n * 32 + (lane & 31);
#if 1
                const int dpos = (kt < 3) ? ((qb - 1 + kt) * 128 + ki) - (qb * 128 + qi) : 0;
                const bool ok = dpos <= 128 && dpos >= -128;
#else
                const bool ok = mode == 0 || (mode == 1 ? ki >= qi : ki <= qi);
#endif
                const float v = ok ? s[n][r] : -1e30f;
                s[n][r] = v; mx = fmaxf(mx, v);
            }
#pragma unroll
            for (int off = 16; off > 0; off >>= 1) mx = fmaxf(mx, __shfl_xor(mx, off));
            const float mnew = fmaxf(mrun[r], mx);
            const float alpha = __expf(mrun[r] - mnew);
            mrun[r] = mnew;
            float ps = 0.f, pv[4];
#pragma unroll
            for (int n = 0; n < 4; n++) { pv[n] = __expf(s[n][r] - mnew); ps += pv[n]; }
            { uint2 w; w.x = pack2(pv[0], pv[1]); w.y = pack2(pv[2], pv[3]);
#ifdef NAT
              w.x &= 0xfffefffeu; w.y &= 0xfffefffeu;
#endif
              *(uint2*)(Pw + (wave * 32 + acc_row(r, lane)) * 136 + 4 * (lane & 31)) = w; }
            lrun[r] = lrun[r] * alpha + ps;
            o[0][r] *= alpha; o[1][r] *= alpha;
        }
        __syncthreads();
        wave_mma_lds<2>(o, Pw + wave * 32 * 136, 136, Vt, 136, 128, lane);
    }
#pragma unroll
    for (int r = 0; r < 16; r++) {
        float ls = lrun[r];
#pragma unroll
        for (int off = 16; off > 0; off >>= 1) ls += __shfl_xor(ls, off);
        ls += __expf(sink - mrun[r]);
        const float inv = 1.f / ls;
        const int row = Rq + wave * 32 + acc_row(r, lane);
#ifdef ATT_T1
        Yc[(size_t)row * 512 + h * 64 + (lane & 31)] = f2bf(inv);
        Yc[(size_t)row * 512 + h * 64 + 32 + (lane & 31)] = f2bf(mrun[r]);
#elif defined(ATT_T2)
        Yc[(size_t)row * 512 + h * 64 + (lane & 31)] = f2bf(o[0][r]);
        Yc[(size_t)row * 512 + h * 64 + 32 + (lane & 31)] = f2bf(o[1][r]);
#else
#ifdef ATT_ZERO_EDGE
        const float zz = (qb == 0 || qb == 15) ? 0.f : 1.f;
#elif defined(ATT_ZERO_MID)
        const float zz = (qb == 5 || qb == 10) ? 0.f : 1.f;
#else
        const float zz = 1.f;
#endif
        Yc[(size_t)row * 512 + h * 64 + (lane & 31)] = f2bf(o[0][r] * inv * zz);
        Yc[(size_t)row * 512 + h * 64 + 32 + (lane & 31)] = f2bf(o[1][r] * inv * zz);
#endif
    }
}


DEV void att_naive_job(const Params& p, int l, int job, int nrows) {
    const bf16_t* P = (const bf16_t*)(p.ws + WS_P);
    const bf16_t* Qa = (const bf16_t*)(p.ws + WS_QA);
    const bf16_t* Ka = (const bf16_t*)(p.ws + WS_KA);
    bf16_t* Yc = (bf16_t*)(p.ws + WS_Y) + (size_t)2 * NTOK * 512;
    const int gid = job * 256 + TID();
    const int R = gid >> 3, h = gid & 7, kvh = h >> 2;
    if (R >= nrows) return;
#ifdef NAIVE_CTX_ONLY
    if (R < NLAT) return;
#endif
#ifdef NAIVE_LAT_ONLY
    if (R >= NLAT) return;
#endif
    float q[64], o[64];
#pragma unroll
    for (int d = 0; d < 64; d++) { q[d] = bf2f(Qa[(size_t)R * 512 + h * 64 + d]); o[d] = 0.f; }
    float m = p.sink[l * 8 + h], lsum = 1.f;
    const bool lat = R < NLAT;
    const int b = lat ? (R >> 11) : ((R - NLAT) >> 8);
    const int t = lat ? (R & 2047) : 0;
    const int nband = lat ? 257 : 0;
    for (int kk = 0; kk < nband + 256; kk++) {
        int Rk;
        if (kk < nband) { const int tk = t - 128 + kk; if (tk < 0 || tk >= SEQ) continue; Rk = b * SEQ + tk; }
        else Rk = NLAT + b * CTX + (kk - nband);
        float sdot = 0.f;
#pragma unroll
        for (int d = 0; d < 64; d++) sdot += q[d] * bf2f(Ka[(size_t)Rk * 128 + kvh * 64 + d]);
        const float mn = fmaxf(m, sdot), al = expf(m - mn), pe = expf(sdot - mn);
        lsum = lsum * al + pe; m = mn;
#pragma unroll
        for (int d = 0; d < 64; d++) o[d] = o[d] * al + pe * bf2f(P[(size_t)Rk * PW + C_ATV + kvh * 64 + d]);
    }
    const float inv = 1.f / lsum;
#pragma unroll
    for (int d = 0; d < 64; d++) Yc[(size_t)R * 512 + h * 64 + d] = f2bf(o[d] * inv);
}
DEV void rg_coeffs(const Params& p, int l, int b, int q, int n, int dir, unsigned char* ldsb) {
    const bf16_t* P = (const bf16_t*)(p.ws + WS_P);
    const int tid = TID(), lane = tid & 63, wave = tid >> 6;
    bf16_t* u16 = (bf16_t*)ldsb;
    bf16_t* wt = u16 + 128 * 72;
    float* a32 = (float*)ldsb;
    float* ub32 = (float*)(ldsb + 36864);
    __syncthreads();
    {
        const int c8 = (tid & 7) * 8, cbase = n * 64 + c8;
        const int seqbase = q < 2 ? NLAT + b * CTX : b * SEQ, ts0 = q < 2 ? q * 128 : (q - 2) * 128, Ls = q < 2 ? CTX : SEQ;
        float cw[4][8], cb[8];
#pragma unroll
        for (int j = 0; j < 8; j++) { cb[j] = p.conv_b[l * 512 + cbase + j];
#pragma unroll
            for (int k = 0; k < 4; k++) cw[k][j] = p.conv_w[(l * 4 + k) * 512 + cbase + j]; }
        for (int ps = 0; ps < 4; ps++) {
            const int t = (tid >> 3) + 32 * ps;
            float a[8];
#pragma unroll
            for (int j = 0; j < 8; j++) a[j] = cb[j];
#pragma unroll
            for (int k = 0; k < 4; k++) {
                const int ts = ts0 + t + k - 2;
                if (ts >= 0 && ts < Ls) {
                    const uint4 v = *(const uint4*)(P + (size_t)(seqbase + ts) * PW + C_RGX + cbase);
                    const unsigned w[4] = {v.x, v.y, v.z, v.w};
#pragma unroll
                    for (int j = 0; j < 8; j++) a[j] += cw[k][j] * bf2f((w[j >> 1] >> (16 * (j & 1))) & 0xffffu);
                }
            }
            *(float4*)(ub32 + t * 64 + c8) = make_float4(a[0], a[1], a[2], a[3]);
            *(float4*)(ub32 + t * 64 + c8 + 4) = make_float4(a[4], a[5], a[6], a[7]);
            uint4 o; o.x = pack2(a[0], a[1]); o.y = pack2(a[2], a[3]); o.z = pack2(a[4], a[5]); o.w = pack2(a[6], a[7]);
#ifdef NRG
            o.x &= 0xfffefffeu; o.y &= 0xfffefffeu; o.z &= 0xfffefffeu; o.w &= 0xfffefffeu;
#endif
            *(uint4*)(u16 + t * 72 + c8) = o;
        }
        const float* wa = p.wa + (size_t)((l * 2 + dir) * 8 + n) * 4096;
        const float* wi = p.wi + (size_t)((l * 2 + dir) * 8 + n) * 4096;
        const int j = tid & 63;
#pragma unroll 4
        for (int it = 0; it < 8; it++) {
            const int i = 2 * ((tid >> 6) + 4 * it);
            *(unsigned*)(wt + j * 72 + i) = pack2(wa[i * 64 + j], wa[(i + 1) * 64 + j]);
            *(unsigned*)(wt + (64 + j) * 72 + i) = pack2(wi[i * 64 + j], wi[(i + 1) * 64 + j]);
        }
    }
    __syncthreads();
    f32x16 acc[4];
#pragma unroll
    for (int nn = 0; nn < 4; nn++)
#pragma unroll
        for (int r = 0; r < 16; r++) acc[nn][r] = 0.f;
    wave_mma_lds<4>(acc, u16 + wave * 32 * 72, 72, wt, 72, 64, lane);
    __syncthreads();
#pragma unroll
    for (int c2 = 0; c2 < 2; c2++) {
        const int ch = c2 * 32 + (lane & 31), c = n * 64 + ch;
        const float lam = p.lam[(l * 2 + dir) * 512 + c];
        const float cl = 8.f * log1pf(__expf(-lam));
        const float ba = p.ba[(l * 2 + dir) * 512 + c], bi = p.bi[(l * 2 + dir) * 512 + c];
#pragma unroll
        for (int r = 0; r < 16; r++) {
            const int t = wave * 32 + acc_row(r, lane);
            const float rr = sigm(acc[c2][r] + ba), ii = sigm(acc[2 + c2][r] + bi);
            const float la = -cl * rr;
            const float av = __expf(la);
            const float bv = sqrtf(-expm1f(2.f * la)) * ii * ub32[t * 64 + ch];
            a32[t * 64 + ch] = av;
            ub32[t * 64 + ch] = bv;
        }
    }
    __syncthreads();
}
DEV void rg_r1_job(const Params& p, int l, int item, unsigned char* ldsb) {
    const int dir = item & 1, n = (item >> 1) & 7, bq = item >> 4, q = bq % 18, b = bq / 18;
    rg_coeffs(p, l, b, q, n, dir, ldsb);
    const float* a32 = (const float*)ldsb;
    const float* b32 = (const float*)(ldsb + 36864);
    float* segP = (float*)(ldsb + 69632);
    float* segH = segP + 256;
    const int tid = TID(), ch = tid & 63, seg = tid >> 6;
    const int tseg = dir ? 3 - seg : seg;
    float Pp = 1.f, hh = 0.f;
#pragma unroll 8
    for (int i = 0; i < 32; i++) { const int t = seg * 32 + (dir ? 31 - i : i); const float a = a32[t * 64 + ch]; hh = a * hh + b32[t * 64 + ch]; Pp *= a; }
    segP[tseg * 64 + ch] = Pp; segH[tseg * 64 + ch] = hh;
    __syncthreads();
    if (seg == 0) {
        float PP = 1.f, H = 0.f;
#pragma unroll
        for (int k = 0; k < 4; k++) { H = segP[k * 64 + ch] * H + segH[k * 64 + ch]; PP *= segP[k * 64 + ch]; }
        float2* rgs = (float2*)(p.ws + WS_RGS);
        rgs[(size_t)((b * 2 + dir) * 18 + q) * 512 + n * 64 + ch] = make_float2(PP, H);
    }
}
DEV void rg_r2_job(const Params& p, int l, int b, int q, int n, unsigned char* ldsb) {
    const bf16_t* P = (const bf16_t*)(p.ws + WS_P);
    bf16_t* Ya = (bf16_t*)(p.ws + WS_Y);
    const float2* rgs = (const float2*)(p.ws + WS_RGS);
    const float* a32 = (const float*)ldsb;
    const float* b32 = (const float*)(ldsb + 36864);
    float* segP = (float*)(ldsb + 69632);
    float* segH = segP + 256;
    const int tid = TID(), ch = tid & 63, seg = tid >> 6, c = n * 64 + ch;
    const int R0 = chunk_row(b, q);
    float hf[32];
#pragma unroll
    for (int dir = 0; dir < 2; dir++) {
        rg_coeffs(p, l, b, q, n, dir, ldsb);
        const int pos = dir ? (q < 2 ? 1 - q : 19 - q) : q;
        float hc = 0.f;
        for (int k = 0; k < pos; k++) { const int qq = dir ? (k < 2 ? 1 - k : 19 - k) : k; const float2 v = rgs[(size_t)((b * 2 + dir) * 18 + qq) * 512 + c]; hc = v.x * hc + v.y; }
        const int tseg = dir ? 3 - seg : seg;
        float Pp = 1.f, hh = 0.f;
#pragma unroll 8
        for (int i = 0; i < 32; i++) { const int t = seg * 32 + (dir ? 31 - i : i); const float a = a32[t * 64 + ch]; hh = a * hh + b32[t * 64 + ch]; Pp *= a; }
        segP[tseg * 64 + ch] = Pp; segH[tseg * 64 + ch] = hh;
        __syncthreads();
        float hs = hc;
        for (int k = 0; k < tseg; k++) hs = segP[k * 64 + ch] * hs + segH[k * 64 + ch];
        if (dir == 0) {
#pragma unroll
            for (int i = 0; i < 32; i++) { const int t = seg * 32 + i; hs = a32[t * 64 + ch] * hs + b32[t * 64 + ch]; hf[i] = hs; }
        } else {
#pragma unroll
            for (int i = 0; i < 32; i++) {
                const int jj = 31 - i, t = seg * 32 + jj;
                hs = a32[t * 64 + ch] * hs + b32[t * 64 + ch];
                const float g = bf2f(P[(size_t)(R0 + t) * PW + C_RGG + c]);
#ifdef NY
                Ya[(size_t)(R0 + t) * 512 + c] = f2bf((hf[jj] + hs) * gelu_tanh(g)) & 0xfffe;
#else
                Ya[(size_t)(R0 + t) * 512 + c] = f2bf((hf[jj] + hs) * gelu_tanh(g));
#endif
            }
        }
    }
}

DEV float log_sigmoid(float x) { return fminf(x, 0.f) - log1pf(__expf(-fabsf(x))); }
DEV void ml_m1_job(const Params& p, int l, int item, bf16_t* lds) {
    const bf16_t* P = (const bf16_t*)(p.ws + WS_P);
    const float* G = (const float*)(p.ws + WS_G);
    const int tid = TID(), lane = tid & 63, wave = tid >> 6;
    const int q = item % 18, chain = item / 18, dir = chain & 1, h = (chain >> 1) & 3, b = chain >> 3;
    const int R0 = chunk_row(b, q);
    bf16_t* As = lds;
    bf16_t* Bs = lds + 128 * 136;
    float* sm = (float*)(lds + 2 * 128 * 136);
    float* ig = sm; float* fl = sm + 128; float* we = sm + 256; float* wv = sm + 384; float* misc = sm + 512;
    __syncthreads();
    if (tid < 128) {
        ig[tid] = G[(size_t)(R0 + tid) * 16 + (2 * dir) * 4 + h] + p.gate_b[l * 16 + (2 * dir) * 4 + h];
        fl[tid] = log_sigmoid(G[(size_t)(R0 + tid) * 16 + (2 * dir + 1) * 4 + h] + p.gate_b[l * 16 + (2 * dir + 1) * 4 + h]);
    }
    __syncthreads();
    if (wave == 0) {
        const int p0 = 2 * lane, s0 = dir ? 127 - p0 : p0, s1 = dir ? 126 - p0 : p0 + 1;
        const float f0 = fl[s0], f1 = fl[s1], c1 = f0 + f1;
        const float sc = wave_scan_add(c1, lane), tot = __shfl(sc, 63), off = sc - c1;
        const float w0 = tot - (off + f0) + ig[s0], w1 = tot - (off + c1) + ig[s1];
        we[s0] = w0; we[s1] = w1;
        const float mx = wave_max(fmaxf(w0, w1));
        if (lane == 0) { misc[0] = mx; misc[1] = tot; float* mls = (float*)(p.ws + WS_MLS); mls[item * 2] = mx; mls[item * 2 + 1] = tot; }
    }
    __syncthreads();
    if (tid < 128) wv[tid] = __expf(we[tid] - misc[0]);
    __syncthreads();
    load_tile_T<128>(As, 136, P + (size_t)R0 * PW + C_MLV + h * 128, PW, wv);
    load_tile_T<128>(Bs, 136, P + (size_t)R0 * PW + C_MLK + h * 128, PW, nullptr);
    __syncthreads();
    f32x16 acc[4];
#pragma unroll
    for (int n = 0; n < 4; n++)
#pragma unroll
        for (int r = 0; r < 16; r++) acc[n][r] = 0.f;
    wave_mma_lds<4>(acc, As + wave * 32 * 136, 136, Bs, 136, 128, lane);
    const float ksc = 0.08838834764831845f;
    float* dC = (float*)(p.ws + WS_DC) + (size_t)item * 16384;
#pragma unroll
    for (int n = 0; n < 4; n++)
#pragma unroll
        for (int r = 0; r < 16; r++) dC[(wave * 32 + acc_row(r, lane)) * 128 + n * 32 + (lane & 31)] = acc[n][r] * ksc;
    {
        const int dk = tid >> 1, hf = tid & 1;
        float s = 0.f;
        for (int i = 0; i < 64; i++) { const int ss = hf * 64 + i; s += bf2f(Bs[dk * 136 + ss]) * wv[ss]; }
        s += __shfl_xor(s, 1);
        if (hf == 0) ((float*)(p.ws + WS_DN))[(size_t)item * 128 + dk] = s * ksc;
    }
}
DEV void ml_m2_job(const Params& p, int item) {
    const int tid = TID(), slice = item & 15, chain = item >> 4, dir = chain & 1;
    const float* dC = (const float*)(p.ws + WS_DC);
    const float* dn = (const float*)(p.ws + WS_DN);
    const float* mls = (const float*)(p.ws + WS_MLS);
    bf16_t* Cin = (bf16_t*)(p.ws + WS_CIN);
    float* nin = (float*)(p.ws + WS_NIN);
    float* min_ = (float*)(p.ws + WS_MIN);
    const int e0 = slice * 1024 + tid * 4;
    float4 C = make_float4(0.f, 0.f, 0.f, 0.f);
    float nv = 0.f, m = 0.f;
    for (int k = 0; k < 18; k++) {
        const int q = dir ? (k < 2 ? 1 - k : 19 - k) : k;
        const int it = chain * 18 + q;
        uint2 o; o.x = pack2(C.x, C.y); o.y = pack2(C.z, C.w);
#ifdef NML
        o.x &= 0xfffefffeu; o.y &= 0xfffefffeu;
#endif
        *(uint2*)(Cin + (size_t)it * 16384 + e0) = o;
        if (slice == 0) { if (tid < 128) nin[(size_t)it * 128 + tid] = nv; if (tid == 0) min_[it] = m; }
        if (k == 17) break;
        const float mloc = mls[it * 2], bend = mls[it * 2 + 1];
        const float mnew = fmaxf(bend + m, mloc);
        const float d1 = __expf(bend + m - mnew), d2 = __expf(mloc - mnew);
        const float4 dc = *(const float4*)(dC + (size_t)it * 16384 + e0);
        C.x = d1 * C.x + d2 * dc.x; C.y = d1 * C.y + d2 * dc.y; C.z = d1 * C.z + d2 * dc.z; C.w = d1 * C.w + d2 * dc.w;
        if (slice == 0 && tid < 128) nv = d1 * nv + d2 * dn[(size_t)it * 128 + tid];
        m = mnew;
    }
}
DEV void ml_m3_job(const Params& p, int l, int b, int h, int q, bf16_t* lds) {
    const bf16_t* P = (const bf16_t*)(p.ws + WS_P);
    const float* G = (const float*)(p.ws + WS_G);
    const bf16_t* Cin = (const bf16_t*)(p.ws + WS_CIN);
    const float* nin = (const float*)(p.ws + WS_NIN);
    const float* min_ = (const float*)(p.ws + WS_MIN);
    bf16_t* Yb = (bf16_t*)(p.ws + WS_Y) + (size_t)NTOK * 512;
    const int tid = TID(), lane = tid & 63, wave = tid >> 6;
    const int R0 = chunk_row(b, q);
    bf16_t* Bs = lds;
    bf16_t* Pw = lds + 128 * 136;
    float* sm = (float*)(lds + 2 * 128 * 136);
    float* ig = sm; float* fl = sm + 128; float* acol = sm + 256; float* Mrow = sm + 384; float* brow = sm + 512; float* nl = sm + 640; float* qn = sm + 768; float* denl = sm + 896; float* decl = sm + 1024; float* bndl = sm + 1152;
    __syncthreads();
    load_tile<128>(Pw, 136, P + (size_t)R0 * PW + C_MLQ + h * 128, PW);
    __syncthreads();
    bf16x8 qf[8];
#pragma unroll
    for (int ks = 0; ks < 8; ks++) qf[ks] = *(const bf16x8*)(Pw + (wave * 32 + (lane & 31)) * 136 + ks * 16 + (lane >> 5) * 8);
    float* Ht = (float*)(p.ws + WS_XN);
    const float ksc = 0.08838834764831845f;
#pragma unroll 1
    for (int dir = 0; dir < 2; dir++) {
        const int it = ((b * 4 + h) * 2 + dir) * 18 + q;
        const float m_in = min_[it];
        __syncthreads();
        if (tid < 128) {
            ig[tid] = G[(size_t)(R0 + tid) * 16 + (2 * dir) * 4 + h] + p.gate_b[l * 16 + (2 * dir) * 4 + h];
            fl[tid] = log_sigmoid(G[(size_t)(R0 + tid) * 16 + (2 * dir + 1) * 4 + h] + p.gate_b[l * 16 + (2 * dir + 1) * 4 + h]);
            nl[tid] = nin[(size_t)it * 128 + tid];
        }
        load_tile<128>(Bs, 136, P + (size_t)R0 * PW + C_MLK + h * 128, PW);
        __syncthreads();
        if (wave == 0) {
            const int p0 = 2 * lane, s0 = dir ? 127 - p0 : p0, s1 = dir ? 126 - p0 : p0 + 1;
            const float f0 = fl[s0], f1 = fl[s1], c1 = f0 + f1;
            const float sc = wave_scan_add(c1, lane), off = sc - c1, b0 = off + f0, b1 = off + c1;
            const float a0 = ig[s0] - b0, a1 = ig[s1] - b1;
            const float sm = wave_scan_max(fmaxf(a0, a1), lane);
            float prev = __shfl_up(sm, 1); if (lane == 0) prev = -3.0e38f;
            const float pm0 = fmaxf(prev, a0);
            brow[s0] = b0; brow[s1] = b1; acol[s0] = a0; acol[s1] = a1;
            Mrow[s0] = fmaxf(m_in, pm0); Mrow[s1] = fmaxf(m_in, sm);
        }
        {
            float s = 0.f;
#pragma unroll
            for (int ks = 0; ks < 8; ks++)
#pragma unroll
                for (int j = 0; j < 8; j++) { s += bf2f((unsigned short)qf[ks][j]) * nl[ks * 16 + (lane >> 5) * 8 + j]; if (j == 7) __builtin_amdgcn_sched_barrier(0); }
            s += __shfl_xor(s, 32);
            if (lane < 32) qn[wave * 32 + lane] = s;
        }
        f32x16 s4[4];
#pragma unroll
        for (int n = 0; n < 4; n++)
#pragma unroll
            for (int r = 0; r < 16; r++) s4[n][r] = 0.f;
        wave_mma_reg<4, 8>(s4, qf, Bs, 136, lane);
        __syncthreads();
        const int lnA = OPQ(lane);
#pragma unroll
        for (int r = 0; r < 16; r++) {
            const int t = wave * 32 + acc_row(r, lnA);
            const float Mt = Mrow[t];
            float ps = 0.f, pv[4];
#pragma unroll
            for (int n = 0; n < 4; n++) {
                const int s = n * 32 + (lnA & 31);
                const bool ok = dir ? (s >= t) : (s <= t);
                pv[n] = ok ? s4[n][r] * ksc * __expf(acol[s] - Mt) : 0.f;
                ps += pv[n];
            }
            { uint2 w; w.x = pack2(pv[0], pv[1]); w.y = pack2(pv[2], pv[3]);
#ifdef NML
              w.x &= 0xfffefffeu; w.y &= 0xfffefffeu;
#endif
              *(uint2*)(Pw + t * 136 + 4 * (lnA & 31)) = w; }
#pragma unroll
            for (int off = 16; off > 0; off >>= 1) ps += __shfl_xor(ps, off);
            const float dc = __expf(m_in - Mt);
            if ((lnA & 31) == 0) { denl[t] = ps + dc * qn[t]; decl[t] = dc; bndl[t] = __expf(-(brow[t] + Mt)); }
            __builtin_amdgcn_sched_barrier(0);
        }
        load_tile<128>(Bs, 136, Cin + (size_t)it * 16384, 128);
        __syncthreads();
        f32x16 num[4];
#pragma unroll
        for (int n = 0; n < 4; n++)
#pragma unroll
            for (int r = 0; r < 16; r++) num[n][r] = 0.f;
        wave_mma_reg<4, 8>(num, qf, Bs, 136, lane);
        const int lnB = OPQ(lane);
#pragma unroll
        for (int r = 0; r < 16; r++) {
            const float dc = decl[wave * 32 + acc_row(r, lnB)];
#pragma unroll
            for (int n = 0; n < 4; n++) num[n][r] *= dc;
        }
        __syncthreads();
        load_tile_TP<128>(Bs, 136, P + (size_t)R0 * PW + C_MLV + h * 128, PW);
        __syncthreads();
        wave_mma_lds<4>(num, Pw + wave * 32 * 136, 136, Bs, 136, 128, lane);
        const int lnC = OPQ(lane);
        if (dir == 0) {
#pragma unroll
            for (int r = 0; r < 16; r++) {
                const int t = wave * 32 + acc_row(r, lnC);
                const float inv = 1.f / fmaxf(fabsf(denl[t]), bndl[t]);
#pragma unroll
                for (int n = 0; n < 4; n++) Ht[(size_t)(R0 + t) * 512 + h * 128 + n * 32 + (lnC & 31)] = num[n][r] * inv;
                __builtin_amdgcn_sched_barrier(0);
            }
        } else {
#pragma unroll
            for (int r = 0; r < 16; r++) {
                const int t = wave * 32 + acc_row(r, lnC);
                const float inv = 1.f / fmaxf(fabsf(denl[t]), bndl[t]);
                float hv[4], ss = 0.f;
#pragma unroll
                for (int n = 0; n < 4; n++) { hv[n] = num[n][r] * inv + Ht[(size_t)(R0 + t) * 512 + h * 128 + n * 32 + (lnC & 31)]; ss += hv[n] * hv[n]; }
#pragma unroll
                for (int off = 16; off > 0; off >>= 1) ss += __shfl_xor(ss, off);
                const float rstd = rsqrtf(ss * (1.f / 128.f) + EPS);
#pragma unroll
                for (int n = 0; n < 4; n++) {
                    const int cc = h * 128 + n * 32 + (lnC & 31);
                    const float og = sigm(bf2f(P[(size_t)(R0 + t) * PW + C_MLO + cc]));
#ifdef NML
                    Yb[(size_t)(R0 + t) * 512 + cc] = f2bf(hv[n] * rstd * p.ml_norm_g[l * 512 + cc] * og) & 0xfffe;
#else
                    Yb[(size_t)(R0 + t) * 512 + cc] = f2bf(hv[n] * rstd * p.ml_norm_g[l * 512 + cc] * og);
#endif
                }
                __builtin_amdgcn_sched_barrier(0);
            }
        }
    }
}

#define XB_TMO      128
#define XB_XCNT(j)  (256  + 64 * (j))
#define XB_XSUB(j)  (1280 + 64 * (j))
#define XB_XGEN(j)  (2304 + 64 * (j))
#define XB_TOP      3328
#define XB_TOPGEN   3392
#define XCD_BAR_WORDS 3456
#define XB_SPIN_CAP (1u << 22)
#define LAS __attribute__((address_space(3)))
DEV unsigned xb_ld(unsigned* p)              { return __hip_atomic_load(p, __ATOMIC_RELAXED, __HIP_MEMORY_SCOPE_AGENT); }
DEV unsigned xb_add(unsigned* p, unsigned v) { return __hip_atomic_fetch_add(p, v, __ATOMIC_RELAXED, __HIP_MEMORY_SCOPE_AGENT); }
DEV unsigned xb_xcc_id() { return (unsigned)__builtin_amdgcn_s_getreg((3 << 11) | 20) & 0xFu; }
#define XB_SPIN(cond, bar) do { unsigned _sp = 0; while (cond) { __builtin_amdgcn_s_sleep(1); \
    if ((++_sp & 255u) == 0u) { if (xb_ld(&(bar)[XB_TMO])) break; if (_sp > XB_SPIN_CAP) { atomicAdd(&(bar)[XB_TMO], 1u); break; } } } } while (0)
struct XcdBarrier { unsigned* bar; unsigned x; volatile LAS unsigned* st; };
DEV XcdBarrier xcd_barrier_post(unsigned* bar, volatile LAS unsigned* st) {
    XcdBarrier b; b.bar = bar; b.x = xb_xcc_id(); b.st = st;
    if (threadIdx.x == 0) (void)xb_add(&bar[XB_XCNT(b.x)], 1u);
    return b;
}
DEV void xcd_barrier_complete(unsigned* bar, unsigned x, unsigned& nloc, unsigned& nx) {
    const unsigned G = gridDim.x * gridDim.y * gridDim.z;
    unsigned sum, cnt, mine, sp = 0u;
    for (;;) {
        sum = 0u; cnt = 0u; mine = 0u;
#pragma unroll
        for (unsigned j = 0; j < 16; ++j) { const unsigned c = xb_ld(&bar[XB_XCNT(j)]); sum += c; cnt += (c > 0u) ? 1u : 0u; mine = (j == x) ? c : mine; }
        if (sum == G) break;
        __builtin_amdgcn_s_sleep(1);
        if ((++sp & 255u) == 0u) { if (xb_ld(&bar[XB_TMO])) break; if (sp > XB_SPIN_CAP) { atomicAdd(&bar[XB_TMO], 1u); break; } }
    }
    nloc = mine > 0u ? mine : 1u; nx = cnt > 0u ? cnt : 1u;
}
DEV void xcd_barrier(const XcdBarrier& b) {
    asm volatile("s_waitcnt vmcnt(0)" ::: "memory");
    __syncthreads();
    if (threadIdx.x == 0) {
        unsigned* bar = b.bar;
        __builtin_amdgcn_s_waitcnt(0);
        unsigned nloc = b.st[0], nx = b.st[1];
        if (nloc == 0u) { xcd_barrier_complete(bar, b.x, nloc, nx); b.st[0] = nloc; b.st[1] = nx; }
        const unsigned old = xb_add(&bar[XB_XSUB(b.x)], 1u);
        const unsigned gen = old / nloc;
        if (old + 1u == (gen + 1u) * nloc) {
            __builtin_amdgcn_fence(__ATOMIC_RELEASE, "agent");
            asm volatile("s_waitcnt vmcnt(0)" ::: "memory");
            const unsigned og = xb_add(&bar[XB_TOP], 1u);
            const unsigned tg = og / nx;
            if (og + 1u == (tg + 1u) * nx) xb_add(&bar[XB_TOPGEN], 1u);
            else XB_SPIN(xb_ld(&bar[XB_TOPGEN]) == tg, bar);
            __builtin_amdgcn_fence(__ATOMIC_ACQUIRE, "agent");
            xb_add(&bar[XB_XGEN(b.x)], 1u);
            asm volatile("s_waitcnt vmcnt(0)" ::: "memory");
        } else {
            XB_SPIN(xb_ld(&bar[XB_XGEN(b.x)]) == gen, bar);
            __builtin_amdgcn_fence(__ATOMIC_ACQUIRE, "agent");
            asm volatile("s_waitcnt vmcnt(0)" ::: "memory");
        }
    }
    __syncthreads();
}
DEV int next_job(unsigned* ctr, volatile unsigned* slot) {
    __syncthreads();
    if (threadIdx.x == 0) *slot = __hip_atomic_fetch_add(ctr, 1u, __ATOMIC_RELAXED, __HIP_MEMORY_SCOPE_AGENT);
    __syncthreads();
    return __builtin_amdgcn_readfirstlane((int)*slot);
}
__global__ void __launch_bounds__(256, 2) fwd_megakernel(Params p) {
    cg::grid_group grid = cg::this_grid();
    extern __shared__ __attribute__((aligned(16))) unsigned char ldsb[];
    bf16_t* lds = (bf16_t*)ldsb;
    const int G_ = gridDim.x, bid = blockIdx.x, tid = threadIdx.x;
    unsigned* bar = (unsigned*)(p.ws + WS_BAR);
    volatile LAS unsigned* xst = (volatile LAS unsigned*)(LAS unsigned char*)(ldsb + LDS_BYTES - 16);
    volatile unsigned* jslot = (volatile unsigned*)(ldsb + LDS_BYTES - 8);
    if (tid == 0) { xst[0] = 0u; xst[1] = 0u; }
    __syncthreads();
    const XcdBarrier xb = xcd_barrier_post(bar, xst);
    if (p.ws == nullptr) grid.sync();
#ifdef REP_BAR
#define GS() do { xcd_barrier(xb); xcd_barrier(xb); } while (0)
#else
#define GS() xcd_barrier(xb)
#endif

    {
        for (int j = bid; j < 576 + NWJOBS; j += G_) { if (j < 576) { PH(1) ada_job(p, j, (float*)ldsb); } else { PH(1) wconv_job(p, 0, j - 576, lds); } }
        float4* X4 = (float4*)(p.ws + WS_X);
        const float4* x4 = (const float4*)p.x; const float4* c4 = (const float4*)p.ctx;
        const size_t nl4 = (size_t)NLAT * D / 4, nt4 = (size_t)NTOK * D / 4;
        for (size_t i = (size_t)bid * 256 + tid; i < nt4; i += (size_t)G_ * 256) X4[i] = i < nl4 ? x4[i] : c4[i - nl4];
    }
    GS();
    const bf16_t* W = (const bf16_t*)(p.ws + WS_W);
    for (int l = 0; l < DEPTH; l++) {
        const bool ctx_out = l < DEPTH - 1;
        const int mt_all = 144, mt_late = ctx_out ? 144 : 128;
        if (l > 0) { for (int rep = 0; rep < REP_NORM; rep++) for (int j = bid; j < NWJOBS; j += G_) wconv_job(p, l, j, lds); }
        for (int rep = 0; rep < REP_NORM; rep++) { PH(2) norm_phase(p, l, 0, NTOK); }
        GS();
        for (int rep = 0; rep < REP_GEMM; rep++) { PH(4) ffn_up_phase(p, 0, mt_all, lds); }
        GS();
        PH(8) resid_gemm_phase<44>(p, l, (const bf16_t*)(p.ws + WS_U), DFF, W + NW13, 2, 0.5f, mt_all, lds);
        GS();
#ifndef SKIP_MIX
        for (int rep = 0; rep < REP_NORM; rep++) norm_phase(p, l, 1, NTOK);
        GS();
        for (int rep = 0; rep < REP_GEMM; rep++) { PH(16) win_phase(p, !ctx_out, lds); }
        GS();
        for (int rep = 0; rep < REP_MIX1; rep++)
        for (int j = bid; j < 1152 + 2304 + 576; j += G_) {
            if (j < 1152) { MX(1) ml_m1_job(p, l, j, lds); }
            else if (j < 3456) { MX(2) rg_r1_job(p, l, j - 1152, ldsb); }
            else { MX(4) attprep_job(p, l, j - 3456); }
        }
        GS();
        {
            const int q0 = ctx_out ? 0 : 2, nq = 18 - q0;
            const int natt = NB * (ctx_out ? 18 : 16) * 8, nr2 = NB * nq * 8;
            for (int rep = 0; rep < REP_MIX2; rep++)
            for (int j = next_job(bar + (l * 4 + 1) * 8, jslot); j < 1024 + natt; j = next_job(bar + (l * 4 + 1) * 8, jslot)) {
                if (j < 1024) { MX(1) ml_m2_job(p, j); }
                else { int i = j - 1024; const int h = i & 7; i >>= 3; const int nqb = ctx_out ? 18 : 16; MX(4) att_job(p, l, i / nqb, i % nqb, h, lds); }
            }
            GS();
#ifdef ATT_NAIVE
            { const int nrows = ctx_out ? NTOK : NLAT; for (int j = bid; j < (nrows * 8 + 255) / 256; j += G_) att_naive_job(p, l, j, nrows); }
#endif
            for (int rep = 0; rep < REP_MIX3; rep++)
            for (int j = next_job(bar + (l * 4 + 2) * 8, jslot); j < NB * 4 * nq + nr2; j = next_job(bar + (l * 4 + 2) * 8, jslot)) {
                if (j < NB * 4 * nq) { const int q = q0 + j % nq, bh = j / nq; MX(1) ml_m3_job(p, l, bh >> 2, bh & 3, q, lds); }
                else { int i = j - NB * 4 * nq; const int n = i & 7; i >>= 3; MX(2) rg_r2_job(p, l, i / nq, q0 + i % nq, n, ldsb); }
            }
        }
        GS();
        for (int rep = 0; rep < REP_GEMM; rep++) { PH(4096) merge_phase(p, mt_late, lds); }
        GS();
        resid_gemm_phase<16>(p, l, (const bf16_t*)(p.ws + WS_XN), D, W + NW13 + NW2 + NWIN + NWB, 5, 1.0f, mt_late, lds);
        GS();
#endif
        for (int rep = 0; rep < REP_NORM; rep++) norm_phase(p, l, 2, mt_late * 128);
        GS();
        for (int rep = 0; rep < REP_GEMM; rep++) ffn_up_phase(p, 1, mt_late, lds);
        GS();
        resid_gemm_phase<44>(p, l, (const bf16_t*)(p.ws + WS_U), DFF, W + NW13 + NW2 / 2, 8, 0.5f, mt_late, lds, ctx_out ? nullptr : p.out);
        if (ctx_out) GS();
    }
}

extern "C" void kernel_launch(void* const* d_in, const int* in_sizes, int n_in, void* d_out, int out_size, void* d_ws, size_t ws_size, hipStream_t stream) {
    static int grid_blocks = 0;
    if (!grid_blocks) {
        int dev = 0, cus = 0, per_cu = 0;
        hipGetDevice(&dev);
        hipDeviceGetAttribute(&cus, hipDeviceAttributeMultiprocessorCount, dev);
        hipFuncSetAttribute((const void*)fwd_megakernel, hipFuncAttributeMaxDynamicSharedMemorySize, LDS_BYTES);
        hipOccupancyMaxActiveBlocksPerMultiprocessor(&per_cu, fwd_megakernel, 256, LDS_BYTES);
        if (per_cu < 1) per_cu = 1;
        if (per_cu > 2) per_cu = 2;
        grid_blocks = cus * per_cu;
        if (ws_size < WS_END) fprintf(stderr, "workspace too small: %zu < %zu\n", ws_size, (size_t)WS_END);
    }
    Params p{};
    const float** f = (const float**)&p;
    for (int i = 0; i < 25; i++) f[i] = (const float*)d_in[i];
    p.out = (float*)d_out;
    p.ws = (unsigned char*)d_ws;
    hipMemsetAsync((char*)d_ws + WS_BAR, 0, 13824, stream);
    void* args[] = {&p};
    hipError_t e = hipLaunchCooperativeKernel((void*)fwd_megakernel, dim3(grid_blocks), dim3(256), args, LDS_BYTES, stream);
    if (e != hipSuccess) fprintf(stderr, "cooperative launch failed: %s (grid %d)\n", hipGetErrorString(e), grid_blocks);
}
```

```cpp
#include <hip/hip_runtime.h>
#include <hip/hip_cooperative_groups.h>
#include <cstdio>
#include <cstdint>
namespace cg = cooperative_groups;

typedef unsigned short bf16_t;
typedef short bf16x8 __attribute__((ext_vector_type(8)));
typedef float f32x16 __attribute__((ext_vector_type(16)));
#define DEV __device__ __forceinline__
DEV int OPQ(int v) { asm volatile("" : "+v"(v)); return v; }
DEV int TID() { int t = threadIdx.x; asm volatile("" : "+v"(t)); return t; }

constexpr int D = 1024, NB = 8, SEQ = 2048, CTX = 256, DEPTH = 4, DFF = 2816;
constexpr int NLAT = NB * SEQ, NTOK = NLAT + NB * CTX;
constexpr int DIN = 6928, PW = 6912, NIN = 7040;
constexpr int NMODC = 9 * D;
constexpr int C_RGX = 0, C_RGG = 512, C_MLQ = 1024, C_MLK = 1536, C_MLV = 2048, C_MLO = 2560, C_ATQ = 3072, C_ATK = 3584, C_ATV = 3712, C_BRG = 3840;
constexpr float EPS = 1e-6f;

constexpr size_t al256(size_t x) { return (x + 255) & ~(size_t)255; }
constexpr size_t WS_X = 0;
constexpr size_t WS_XN = WS_X + al256((size_t)NTOK * D * 4);
constexpr size_t WS_U = WS_XN + al256((size_t)NTOK * D * 2);
constexpr size_t WS_P = WS_U + al256((size_t)NTOK * DFF * 2);
constexpr size_t WS_G = WS_P + al256((size_t)NTOK * PW * 2);
constexpr size_t NW13 = (size_t)2 * 5632 * 1024, NW2 = (size_t)2 * 1024 * 2816, NWIN = (size_t)NIN * 1024, NWB = (size_t)3 * 1024 * 512, NWO = (size_t)1024 * 1024;
constexpr size_t WS_W = WS_G + al256((size_t)NTOK * 16 * 4);
constexpr size_t WS_Y = WS_W + al256((NW13 + NW2 + NWIN + NWB + NWO) * 2);
constexpr size_t WS_CIN = WS_Y + al256((size_t)3 * NTOK * 512 * 2);
constexpr size_t WS_MOD = WS_CIN + al256((size_t)64 * 18 * 16384 * 2);
constexpr size_t WS_DN = WS_MOD + al256((size_t)DEPTH * NMODC * 9 * 4);
constexpr size_t WS_MLS = WS_DN + al256((size_t)1152 * 128 * 4);
constexpr size_t WS_NIN = WS_MLS + al256((size_t)1152 * 2 * 4);
constexpr size_t WS_MIN = WS_NIN + al256((size_t)1152 * 128 * 4);
constexpr size_t WS_RGS = WS_MIN + al256((size_t)1152 * 4);
constexpr size_t WS_BAR = WS_RGS + al256((size_t)NB * 2 * 18 * 512 * 2 * 4);
constexpr size_t WS_END = WS_BAR + 13824;
constexpr size_t WS_DC = WS_U;
constexpr size_t WS_QA = WS_DC + al256((size_t)1152 * 16384 * 4);
constexpr size_t WS_KA = WS_QA + al256((size_t)NTOK * 512 * 2);
static_assert(WS_KA + (size_t)NTOK * 128 * 2 <= WS_P, "overlay overflow");

constexpr int LDS_BYTES = 80 * 1024;
#ifndef REP_GEMM
#define REP_GEMM 1
#endif
#ifndef REP_MIX1
#define REP_MIX1 1
#endif
#ifndef REP_MIX2
#define REP_MIX2 1
#endif
#ifndef REP_MIX3
#define REP_MIX3 1
#endif
#ifndef REP_NORM
#define REP_NORM 1
#endif
#ifndef PHMASK
#define PHMASK 0xffff
#endif
#define PH(x) if ((PHMASK) & (x))
#ifndef MIXMASK
#define MIXMASK 7
#endif
#define MX(x) if ((MIXMASK) & (x))

struct Params {
    const float *x, *c, *ctx, *c_ctx, *ada_w, *ada_b, *norm_g, *w1, *w3, *w2, *w_in, *conv_w, *conv_b, *wa, *ba, *wi, *bi, *lam,
        *gate_b, *ml_norm_g, *qn_g, *kn_g, *sink, *w_branch, *w_out;
    float* out;
    unsigned char* ws;
};

DEV float bf2f(unsigned h) { return __uint_as_float(h << 16); }
typedef float f32x2_t __attribute__((ext_vector_type(2)));
typedef __bf16 bf16x2_t __attribute__((ext_vector_type(2)));
DEV unsigned pack2(float lo, float hi) { f32x2_t v = {lo, hi}; bf16x2_t b = __builtin_convertvector(v, bf16x2_t);
#ifdef NOISY
    return __builtin_bit_cast(unsigned, b) & 0xfffefffeu; }
#else
    return __builtin_bit_cast(unsigned, b); }
#endif
DEV bf16_t f2bf(float f) { return (bf16_t)(pack2(f, 0.f) & 0xffffu); }
DEV float sigm(float x) { return __builtin_amdgcn_rcpf(1.f + __expf(-x)); }
DEV float gelu_tanh(float x) { float u = 0.7978845608028654f * (x + 0.044715f * x * x * x); return x * sigm(2.f * u); }
DEV int acc_row(int reg, int lane) { return (reg & 3) + 8 * (reg >> 2) + 4 * (lane >> 5); }
DEV int chunk_row(int b, int q) { return q < 2 ? NLAT + b * CTX + q * 128 : b * SEQ + (q - 2) * 128; }
DEV int mod_of_row(int r) { return r < NLAT ? (r >> 11) : 8; }
DEV float wave_sum(float v) {
#pragma unroll
    for (int o = 32; o > 0; o >>= 1) v += __shfl_xor(v, o);
    return v;
}
DEV float wave_scan_add(float v, int lane) {
#pragma unroll
    for (int o = 1; o < 64; o <<= 1) { const float t = __shfl_up(v, o); if (lane >= o) v += t; }
    return v;
}
DEV float wave_scan_max(float v, int lane) {
#pragma unroll
    for (int o = 1; o < 64; o <<= 1) { const float t = __shfl_up(v, o); if (lane >= o) v = fmaxf(v, t); }
    return v;
}
DEV float wave_max(float v) {
#pragma unroll
    for (int o = 32; o > 0; o >>= 1) v = fmaxf(v, __shfl_xor(v, o));
    return v;
}
DEV f32x16 mfma(bf16x8 a, bf16x8 b, f32x16 c) { return __builtin_amdgcn_mfma_f32_32x32x16_bf16(a, b, c, 0, 0, 0); }

template <int NT> DEV void wave_mma_lds(f32x16 (&acc)[NT], const bf16_t* As, int sa, const bf16_t* Bs, int sb, int K, int lane) {
    const bf16_t* ap = As + (lane & 31) * sa + (lane >> 5) * 8;
    const bf16_t* bp = Bs + (lane & 31) * sb + (lane >> 5) * 8;
#pragma unroll 2
    for (int k = 0; k < K; k += 16) {
        bf16x8 a = *(const bf16x8*)(ap + k);
#pragma unroll
        for (int n = 0; n < NT; n++) { bf16x8 b = *(const bf16x8*)(bp + n * 32 * sb + k); acc[n] = mfma(a, b, acc[n]); }
    }
}
template <int NT, int KS> DEV void wave_mma_reg(f32x16 (&acc)[NT], const bf16x8 (&af)[KS], const bf16_t* Bs, int sb, int lane) {
    const bf16_t* bp = Bs + (lane & 31) * sb + (lane >> 5) * 8;
#pragma unroll
    for (int ks = 0; ks < KS; ks++) {
#pragma unroll
        for (int n = 0; n < NT; n++) { bf16x8 b = *(const bf16x8*)(bp + n * 32 * sb + ks * 16); acc[n] = mfma(af[ks], b, acc[n]); }
        __builtin_amdgcn_sched_barrier(0);
    }
}
template <int NC> DEV void load_tile(bf16_t* dst, int S, const bf16_t* src, size_t ld) {
    constexpr int CPR = NC / 8;
    for (int c = TID(); c < 128 * CPR; c += 256) { int r = c / CPR, kc = c % CPR; *(uint4*)(dst + r * S + kc * 8) = *(const uint4*)(src + (size_t)r * ld + kc * 8); }
}
template <int ND> DEV void load_tile_T(bf16_t* dst, int S, const bf16_t* src, size_t ld, const float* tokscale) {
    constexpr int DC = ND / 8;
    for (int c = TID(); c < 64 * DC; c += 256) {
        int tp = c & 63, dc = c >> 6;
        uint4 v0 = *(const uint4*)(src + (size_t)(2 * tp) * ld + dc * 8), v1 = *(const uint4*)(src + (size_t)(2 * tp + 1) * ld + dc * 8);
        unsigned w0[4] = {v0.x, v0.y, v0.z, v0.w}, w1[4] = {v1.x, v1.y, v1.z, v1.w};
        float s0 = 1.f, s1 = 1.f;
        if (tokscale) { s0 = tokscale[2 * tp]; s1 = tokscale[2 * tp + 1]; }
#pragma unroll
        for (int j = 0; j < 8; j++) {
            unsigned e0 = (w0[j >> 1] >> (16 * (j & 1))) & 0xffffu, e1 = (w1[j >> 1] >> (16 * (j & 1))) & 0xffffu;
            unsigned o;
            if (tokscale) o = pack2(bf2f(e0) * s0, bf2f(e1) * s1); else o = e0 | (e1 << 16);
            *(unsigned*)(dst + (dc * 8 + j) * S + 2 * tp) = o;
        }
    }
}

template <int ND> DEV void load_tile_TP(bf16_t* dst, int S, const bf16_t* src, size_t ld) {
    constexpr int DC = ND / 8;
    for (int c = TID(); c < 64 * DC; c += 256) {
        const int tp = c & 63, dc = c >> 6, l = tp & 31, g = tp >> 5, t0 = l + 64 * g, t1 = t0 + 32;
        uint4 v0 = *(const uint4*)(src + (size_t)t0 * ld + dc * 8), v1 = *(const uint4*)(src + (size_t)t1 * ld + dc * 8);
        unsigned w0[4] = {v0.x, v0.y, v0.z, v0.w}, w1[4] = {v1.x, v1.y, v1.z, v1.w};
#pragma unroll
        for (int j = 0; j < 8; j++) {
            unsigned e0 = (w0[j >> 1] >> (16 * (j & 1))) & 0xffffu, e1 = (w1[j >> 1] >> (16 * (j & 1))) & 0xffffu;
            *(unsigned*)(dst + (dc * 8 + j) * S + 4 * l + 2 * g) = e0 | (e1 << 16);
        }
    }
}

constexpr int GS = 72;
template <int NI> DEV void k_compute(f32x16 (&acc)[2][NI], const bf16_t* cA, const bf16_t* cB, int fa, int fb) {
    __builtin_amdgcn_s_setprio(1);
#pragma unroll
    for (int ks = 0; ks < 4; ks++) {
        bf16x8 a0 = *(const bf16x8*)(cA + fa + ks * 16), a1 = *(const bf16x8*)(cA + fa + 32 * GS + ks * 16);
#pragma unroll
        for (int ni = 0; ni < NI; ni++) {
            bf16x8 b0 = *(const bf16x8*)(cB + fb + ni * 32 * GS + ks * 16);
            acc[0][ni] = mfma(b0, a0, acc[0][ni]); acc[1][ni] = mfma(b0, a1, acc[1][ni]);
        }
    }
    __builtin_amdgcn_s_setprio(0);
}
typedef unsigned u32x4 __attribute__((ext_vector_type(4)));
struct RegSet { u32x4 a0, a1, a2, a3, b0, b1, b2, b3; };
template <int NI> DEV void rs_load(RegSet& r, const bf16_t* a, const bf16_t* b, int lda, int ldb) {
    r.a0 = *(const u32x4*)(a); r.a1 = *(const u32x4*)(a + (size_t)32 * lda); r.a2 = *(const u32x4*)(a + (size_t)64 * lda); r.a3 = *(const u32x4*)(a + (size_t)96 * lda);
    r.b0 = *(const u32x4*)(b); r.b1 = *(const u32x4*)(b + (size_t)32 * ldb);
    if (NI == 2) { r.b2 = *(const u32x4*)(b + (size_t)64 * ldb); r.b3 = *(const u32x4*)(b + (size_t)96 * ldb); }
}
template <int NI> DEV void rs_store(const RegSet& r, bf16_t* sa, bf16_t* sb) {
    *(u32x4*)(sa) = r.a0; *(u32x4*)(sa + 32 * GS) = r.a1; *(u32x4*)(sa + 64 * GS) = r.a2; *(u32x4*)(sa + 96 * GS) = r.a3;
    *(u32x4*)(sb) = r.b0; *(u32x4*)(sb + 32 * GS) = r.b1;
    if (NI == 2) { *(u32x4*)(sb + 64 * GS) = r.b2; *(u32x4*)(sb + 96 * GS) = r.b3; }
}
template <int NI, int NK = 0> DEV void gemm_kloop(f32x16 (&acc)[2][NI], const bf16_t* __restrict__ A, int lda, const bf16_t* __restrict__ B, int ldb, int K, bf16_t* lds,
                                      const bf16_t* nA, const bf16_t* nB, int nlda, int nldb, bool first, RegSet& p, RegSet& q) {
    const int tid = TID(), lane = tid & 63, wave = tid >> 6, wr = wave >> 1, wc = wave & 1;
    bf16_t* sA = lds;
    bf16_t* sB = lds + 2 * 128 * GS;
    const int lrow = tid >> 3, lkc = (tid & 7) * 8;
    const bf16_t* ga = A + (size_t)lrow * lda + lkc;
    const bf16_t* gb = B + (size_t)lrow * ldb + lkc;
    const bool hasn = nA != nullptr;
    const bf16_t* na = hasn ? nA + (size_t)lrow * nlda + lkc : ga;
    const bf16_t* nb = hasn ? nB + (size_t)lrow * nldb + lkc : gb;
    const int so = lrow * GS + lkc;
    const int nk = NK > 0 ? NK : (K >> 6);
    const int fa = (wr * 64 + (lane & 31)) * GS + (lane >> 5) * 8;
    const int fb = (wc * 32 * NI + (lane & 31)) * GS + (lane >> 5) * 8;
    if (first) {
        rs_load<NI>(p, ga, gb, lda, ldb);
        rs_store<NI>(p, sA + so, sB + so);
        rs_load<NI>(p, ga + 64, gb + 64, lda, ldb);
        rs_load<NI>(q, ga + 128, gb + 128, lda, ldb);
        __syncthreads();
    }
#pragma unroll (NK > 0 ? NK / 2 : 1)
    for (int kt = 0; kt < nk; kt += 2) {
        k_compute<NI>(acc, sA, sB, fa, fb);
        rs_store<NI>(p, sA + 128 * GS + so, sB + 128 * GS + so);
        if (kt + 3 < nk) rs_load<NI>(p, ga + (size_t)(kt + 3) * 64, gb + (size_t)(kt + 3) * 64, lda, ldb);
        else if (hasn) rs_load<NI>(p, na + (size_t)(kt + 3 - nk) * 64, nb + (size_t)(kt + 3 - nk) * 64, nlda, nldb);
        __syncthreads();
        k_compute<NI>(acc, sA + 128 * GS, sB + 128 * GS, fa, fb);
        if (kt + 2 < nk || hasn) rs_store<NI>(q, sA + so, sB + so);
        if (kt + 4 < nk) rs_load<NI>(q, ga + (size_t)(kt + 4) * 64, gb + (size_t)(kt + 4) * 64, lda, ldb);
        else if (hasn) rs_load<NI>(q, na + (size_t)(kt + 4 - nk) * 64, nb + (size_t)(kt + 4 - nk) * 64, nlda, nldb);
        __syncthreads();
    }
}
DEV void tile_of(int t, int mtiles, int ntiles, int& mt, int& nt) {
    const int nig = 32 * ntiles, gid = t / nig, fm = gid * 32, gsz = min(mtiles - fm, 32);
    mt = fm + (t % nig) % gsz; nt = (t % nig) / gsz;
}
template <int NI> DEV void zero_acc(f32x16 (&acc)[2][NI]) {
#pragma unroll
    for (int i = 0; i < 2; i++)
#pragma unroll
        for (int j = 0; j < NI; j++)
#pragma unroll
            for (int r = 0; r < 16; r++) acc[i][j][r] = 0.f;
}

DEV void wconv_job(const Params& p, int l, int job, bf16_t* lds) {
    bf16_t* W = (bf16_t*)(p.ws + WS_W);
    const int tid = TID();
    int mat, sub = 0, K, ntl;
    bf16_t* dst;
    if (job < 2816) { mat = 0; sub = job / 1408; job %= 1408; K = 1024; dst = W + (size_t)sub * 5632 * 1024; }
    else if (job < 4224) { job -= 2816; mat = 1; sub = job / 704; job %= 704; K = 2816; dst = W + NW13 + (size_t)sub * 1024 * 2816; }
    else if (job < 5984) { job -= 4224; mat = 2; K = 1024; dst = W + NW13 + NW2; }
    else if (job < 6368) { job -= 5984; mat = 3; sub = job / 128; job %= 128; K = 512; dst = W + NW13 + NW2 + NWIN + (size_t)sub * 1024 * 512; }
    else { job -= 6368; mat = 4; K = 1024; dst = W + NW13 + NW2 + NWIN + NWB; }
    const int ktl = K / 64;
    ntl = job / ktl; const int kt = job % ktl;
    const int n0 = ntl * 64, k0 = kt * 64;
    const int nn = tid & 63, np = n0 + nn;
    const float* colp = nullptr; size_t ld = 0;
    if (mat == 0) { int g = np >> 6, s = (np >> 5) & 1, j = np & 31; colp = (s ? p.w3 : p.w1) + ((size_t)(l * 2 + sub) * 1024) * DFF + g * 32 + j; ld = DFF; }
    else if (mat == 1) { colp = p.w2 + ((size_t)(l * 2 + sub) * DFF) * 1024 + np; ld = 1024; }
    else if (mat == 2) { int oc = np < 3072 ? np : (np < 6912 ? np + 16 : (np < 6928 ? np - 6912 + 3072 : -1)); if (oc >= 0) colp = p.w_in + (size_t)l * 1024 * DIN + oc; ld = DIN; }
    else if (mat == 3) { colp = p.w_branch + ((size_t)(l * 3 + sub) * 512) * 1024 + np; ld = 1024; }
    else { colp = p.w_out + (size_t)l * 1024 * 1024 + np; ld = 1024; }
    bf16_t* tl = lds;
#pragma unroll 4
    for (int it = 0; it < 8; it++) {
        const int kk = 2 * ((tid >> 6) + 4 * it);
        const float v0 = colp ? colp[(size_t)(k0 + kk) * ld] : 0.f, v1 = colp ? colp[(size_t)(k0 + kk + 1) * ld] : 0.f;
#ifdef NW
        *(unsigned*)(tl + nn * 66 + kk) = pack2(v0, v1) & 0xfffefffeu;
#else
        *(unsigned*)(tl + nn * 66 + kk) = pack2(v0, v1);
#endif
    }
    __syncthreads();
#pragma unroll
    for (int it = 0; it < 2; it++) {
        int ch = tid + 256 * it, r = ch >> 3, kc = ch & 7;
        const unsigned* s = (const unsigned*)(tl + r * 66 + kc * 8);
        uint4 v; v.x = s[0]; v.y = s[1]; v.z = s[2]; v.w = s[3];
        *(uint4*)(dst + (size_t)(n0 + r) * K + k0 + kc * 8) = v;
    }
    __syncthreads();
}
constexpr int NWJOBS = 6624;

DEV void ada_job(const Params& p, int job, float* lds) {
    const int tid = TID();
    const int l = job / 144, n0 = (job % 144) * 64;
    float* sc = lds;
    float* red = lds + 9 * 1024;
    __syncthreads();
    for (int i = tid; i < 9 * 1024; i += 256) { float v = i < 8192 ? p.c[i] : p.c_ctx[i - 8192]; sc[i] = v * sigm(v); }
    __syncthreads();
    const int cg = tid & 15, kg = tid >> 4;
    const float* w = p.ada_w + ((size_t)l * 1024 + kg * 64) * NMODC + n0 + cg * 4;
    float4 a[9];
#pragma unroll
    for (int m = 0; m < 9; m++) a[m] = make_float4(0.f, 0.f, 0.f, 0.f);
#pragma unroll 8
    for (int k = 0; k < 64; k++) {
        const float4 wv = *(const float4*)(w + (size_t)k * NMODC);
#pragma unroll
        for (int m = 0; m < 9; m++) { const float sv = sc[m * 1024 + kg * 64 + k]; a[m].x += sv * wv.x; a[m].y += sv * wv.y; a[m].z += sv * wv.z; a[m].w += sv * wv.w; }
    }
#pragma unroll
    for (int m = 0; m < 9; m++) *(float4*)(red + (kg * 9 + m) * 64 + cg * 4) = a[m];
    __syncthreads();
    float* mod = (float*)(p.ws + WS_MOD);
    for (int i = tid; i < 9 * 64; i += 256) {
        const int m = i >> 6, cc = i & 63;
        float sum = 0.f;
#pragma unroll
        for (int g = 0; g < 16; g++) sum += red[(g * 9 + m) * 64 + cc];
        mod[((size_t)l * 9 + m) * NMODC + n0 + cc] = sum + p.ada_b[(size_t)l * NMODC + n0 + cc];
    }
    __syncthreads();
}

DEV void norm_phase(const Params& p, int l, int which, int nrows) {
    const float* X = (const float*)(p.ws + WS_X);
    bf16_t* XN = (bf16_t*)(p.ws + WS_XN);
    const float* mod = (const float*)(p.ws + WS_MOD) + (size_t)l * 9 * NMODC;
    const float* g = p.norm_g + ((size_t)l * 3 + which) * D;
    const int lane = TID() & 63, gw = blockIdx.x * 4 + (TID() >> 6), nw = gridDim.x * 4;
    for (int r = gw; r < nrows; r += nw) {
        const float4* xr = (const float4*)(X + (size_t)r * D);
        float4 v[4]; float ss = 0.f;
#pragma unroll
        for (int i = 0; i < 4; i++) { v[i] = xr[2 * lane + (i & 1) + 128 * (i >> 1)]; ss += v[i].x * v[i].x + v[i].y * v[i].y + v[i].z * v[i].z + v[i].w * v[i].w; }
        ss = wave_sum(ss);
        const float rstd = rsqrtf(ss * (1.f / D) + EPS);
        const float* mrow = mod + (size_t)mod_of_row(r) * NMODC;
#pragma unroll
        for (int h = 0; h < 2; h++) {
            unsigned w[4];
#pragma unroll
            for (int q = 0; q < 2; q++) {
                const int i = 2 * h + q, c = 8 * lane + 4 * q + 512 * h;
                const float4 gg = *(const float4*)(g + c), sh = *(const float4*)(mrow + (3 * which) * D + c), sc = *(const float4*)(mrow + (3 * which + 1) * D + c);
                const float y0 = v[i].x * rstd * gg.x * (1.f + sc.x) + sh.x, y1 = v[i].y * rstd * gg.y * (1.f + sc.y) + sh.y;
                const float y2 = v[i].z * rstd * gg.z * (1.f + sc.z) + sh.z, y3 = v[i].w * rstd * gg.w * (1.f + sc.w) + sh.w;
                w[2 * q] = pack2(y0, y1); w[2 * q + 1] = pack2(y2, y3);
            }
            uint4 o; o.x = w[0]; o.y = w[1]; o.z = w[2]; o.w = w[3];
            *(uint4*)(XN + (size_t)r * D + 8 * lane + 512 * h) = o;
        }
    }
}

DEV void ffn_up_phase(const Params& p, int f, int mtiles, bf16_t* lds) {
    const bf16_t* A = (const bf16_t*)(p.ws + WS_XN);
    const bf16_t* Bt = (const bf16_t*)(p.ws + WS_W) + (size_t)f * 5632 * 1024;
    bf16_t* U = (bf16_t*)(p.ws + WS_U);
    const int tid = TID(), lane = tid & 63, wave = tid >> 6, wr = wave >> 1, wc = wave & 1;
    const int ntiles = 44, tot = mtiles * ntiles;
    RegSet rp = {}, rq = {}; bool first = true;
    for (int t = blockIdx.x; t < tot; t += gridDim.x) {
        int mt, nt; tile_of(t, mtiles, ntiles, mt, nt);
        const bool hasn = t + (int)gridDim.x < tot; int mt2 = 0, nt2 = 0; if (hasn) tile_of(t + gridDim.x, mtiles, ntiles, mt2, nt2);
        f32x16 acc[2][2]; zero_acc<2>(acc);
        gemm_kloop<2, 16>(acc, A + (size_t)mt * 128 * D, D, Bt + (size_t)nt * 128 * D, D, D, lds, hasn ? A + (size_t)mt2 * 128 * D : nullptr, hasn ? Bt + (size_t)nt2 * 128 * D : nullptr, D, D, first, rp, rq);
        first = false;
#pragma unroll
        for (int mi = 0; mi < 2; mi++) {
            const int row = mt * 128 + wr * 64 + mi * 32 + (lane & 31);
#pragma unroll
            for (int g = 0; g < 4; g++) {
                const int ucol = nt * 64 + wc * 32 + 8 * g + 4 * (lane >> 5);
                float u[4];
#pragma unroll
                for (int j = 0; j < 4; j++) { const float h1 = acc[mi][0][4 * g + j], h3 = acc[mi][1][4 * g + j]; u[j] = h1 * sigm(h1) * h3; }
                uint2 o; o.x = pack2(u[0], u[1]); o.y = pack2(u[2], u[3]);
                *(uint2*)(U + (size_t)row * DFF + ucol) = o;
            }
        }
    }
}
template <int NK> DEV void resid_gemm_phase(const Params& p, int l, const bf16_t* A, int K, const bf16_t* Bt, int gidx, float scale, int mtiles, bf16_t* lds, float* outp = nullptr) {
    float* X = (float*)(p.ws + WS_X);
    const float* mod = (const float*)(p.ws + WS_MOD) + (size_t)l * 9 * NMODC;
    const int tid = TID(), lane = tid & 63, wave = tid >> 6, wr = wave >> 1, wc = wave & 1;
    const int ntiles = 8, tot = mtiles * ntiles, G = gridDim.x;
    const int tfull = (tot / G) * G;
    {
        RegSet rp = {}, rq = {}; bool first = true;
        for (int t = blockIdx.x; t < tfull; t += G) {
            int mt, nt; tile_of(t, mtiles, ntiles, mt, nt);
            const bool hasn = t + G < tfull; int mt2 = 0, nt2 = 0; if (hasn) tile_of(t + G, mtiles, ntiles, mt2, nt2);
            f32x16 acc[2][2]; zero_acc<2>(acc);
            gemm_kloop<2, NK>(acc, A + (size_t)mt * 128 * K, K, Bt + (size_t)nt * 128 * K, K, K, lds, hasn ? A + (size_t)mt2 * 128 * K : nullptr, hasn ? Bt + (size_t)nt2 * 128 * K : nullptr, K, K, first, rp, rq);
            first = false;
            const float* mrow = mod + (size_t)mod_of_row(mt * 128) * NMODC + gidx * D;
#pragma unroll
            for (int ni = 0; ni < 2; ni++)
#pragma unroll
                for (int g = 0; g < 4; g++) {
                    const int col = nt * 128 + wc * 64 + ni * 32 + 8 * g + 4 * (lane >> 5);
                    const float4 gt = *(const float4*)(mrow + col);
#pragma unroll
                    for (int mi = 0; mi < 2; mi++) {
                        const int row = mt * 128 + wr * 64 + mi * 32 + (lane & 31);
                        float4* xp = (float4*)(X + (size_t)row * D + col);
                        float4 xv = *xp;
                        xv.x += scale * gt.x * acc[mi][ni][4 * g + 0]; xv.y += scale * gt.y * acc[mi][ni][4 * g + 1];
                        xv.z += scale * gt.z * acc[mi][ni][4 * g + 2]; xv.w += scale * gt.w * acc[mi][ni][4 * g + 3];
                        if (outp) *(float4*)(outp + (size_t)row * D + col) = xv; else *xp = xv;
                    }
                }
        }
    }
    {
        const int nhalf = 2 * (tot - tfull);
        RegSet rp = {}, rq = {};
        for (int h = blockIdx.x; h < nhalf; h += G) {
            int mt, nt; tile_of(tfull + (h >> 1), mtiles, ntiles, mt, nt);
            const int nt2 = nt * 2 + (h & 1);
            f32x16 acc[2][1]; zero_acc<1>(acc);
            gemm_kloop<1, NK>(acc, A + (size_t)mt * 128 * K, K, Bt + (size_t)nt2 * 64 * K, K, K, lds, nullptr, nullptr, K, K, true, rp, rq);
            const float* mrow = mod + (size_t)mod_of_row(mt * 128) * NMODC + gidx * D;
#pragma unroll
            for (int g = 0; g < 4; g++) {
                const int col = nt2 * 64 + wc * 32 + 8 * g + 4 * (lane >> 5);
                const float4 gt = *(const float4*)(mrow + col);
#pragma unroll
                for (int mi = 0; mi < 2; mi++) {
                    const int row = mt * 128 + wr * 64 + mi * 32 + (lane & 31);
                    float4* xp = (float4*)(X + (size_t)row * D + col);
                    float4 xv = *xp;
                    xv.x += scale * gt.x * acc[mi][0][4 * g + 0]; xv.y += scale * gt.y * acc[mi][0][4 * g + 1];
                    xv.z += scale * gt.z * acc[mi][0][4 * g + 2]; xv.w += scale * gt.w * acc[mi][0][4 * g + 3];
                    if (outp) *(float4*)(outp + (size_t)row * D + col) = xv; else *xp = xv;
                }
            }
        }
    }
}
DEV void win_tile_of(int t, bool last, int& mt, int& nt) {
    if (!last) { tile_of(t, 144, 55, mt, nt); return; }
    if (t < 128 * 55) { tile_of(t, 128, 55, mt, nt); return; }
    const int u = t - 128 * 55, k = u >> 4;
    mt = 128 + (u & 15);
    nt = k < 4 ? k : (k < 12 ? 8 + k : (k < 14 ? 16 + k : 54));
}
DEV void win_phase(const Params& p, bool last, bf16_t* lds) {
    const bf16_t* A = (const bf16_t*)(p.ws + WS_XN);
    const bf16_t* Bt = (const bf16_t*)(p.ws + WS_W) + NW13 + NW2;
    bf16_t* P = (bf16_t*)(p.ws + WS_P);
    float* G = (float*)(p.ws + WS_G);
    const int tid = TID(), lane = tid & 63, wave = tid >> 6, wr = wave >> 1, wc = wave & 1;
    const int tot = last ? 128 * 55 + 16 * 15 : 144 * 55;
    RegSet rp = {}, rq = {}; bool first = true;
    for (int t = blockIdx.x; t < tot; t += gridDim.x) {
        int mt, nt; win_tile_of(t, last, mt, nt);
        const bool hasn = t + (int)gridDim.x < tot; int mt2 = 0, nt2 = 0; if (hasn) win_tile_of(t + gridDim.x, last, mt2, nt2);
        f32x16 acc[2][2]; zero_acc<2>(acc);
        gemm_kloop<2, 16>(acc, A + (size_t)mt * 128 * D, D, Bt + (size_t)nt * 128 * D, D, D, lds, hasn ? A + (size_t)mt2 * 128 * D : nullptr, hasn ? Bt + (size_t)nt2 * 128 * D : nullptr, D, D, first, rp, rq);
        first = false;
        if (nt < 54) {
            const int hh = lane >> 5;
#pragma unroll
            for (int ni = 0; ni < 2; ni++)
#pragma unroll
                for (int mi = 0; mi < 2; mi++) {
                    const int row = mt * 128 + wr * 64 + mi * 32 + (lane & 31);
#pragma unroll
                    for (int gp = 0; gp < 2; gp++) {
                        const int g0 = 2 * gp, g1 = g0 + 1;
                        const unsigned a0 = pack2(acc[mi][ni][4 * g0], acc[mi][ni][4 * g0 + 1]), a1 = pack2(acc[mi][ni][4 * g0 + 2], acc[mi][ni][4 * g0 + 3]);
                        const unsigned b0 = pack2(acc[mi][ni][4 * g1], acc[mi][ni][4 * g1 + 1]), b1 = pack2(acc[mi][ni][4 * g1 + 2], acc[mi][ni][4 * g1 + 3]);
                        const unsigned s0 = hh ? a0 : b0, s1 = hh ? a1 : b1;
                        const unsigned r0 = (unsigned)__shfl_xor((int)s0, 32), r1 = (unsigned)__shfl_xor((int)s1, 32);
                        uint4 o;
                        if (hh == 0) { o.x = a0; o.y = a1; o.z = r0; o.w = r1; }
                        else { o.x = r0; o.y = r1; o.z = b0; o.w = b1; }
                        const int col = nt * 128 + wc * 64 + ni * 32 + 16 * gp + 8 * hh;
                        *(uint4*)(P + (size_t)row * PW + col) = o;
                    }
                }
        } else {
#pragma unroll
        for (int ni = 0; ni < 2; ni++)
#pragma unroll
            for (int g = 0; g < 4; g++) {
                const int col = nt * 128 + wc * 64 + ni * 32 + 8 * g + 4 * (lane >> 5);
#pragma unroll
                for (int mi = 0; mi < 2; mi++) {
                    const int row = mt * 128 + wr * 64 + mi * 32 + (lane & 31);
                    if (col < PW) { uint2 o; o.x = pack2(acc[mi][ni][4 * g], acc[mi][ni][4 * g + 1]); o.y = pack2(acc[mi][ni][4 * g + 2], acc[mi][ni][4 * g + 3]); *(uint2*)(P + (size_t)row * PW + col) = o; }
                    else if (col < PW + 16) *(float4*)(G + (size_t)row * 16 + (col - PW)) = make_float4(acc[mi][ni][4 * g], acc[mi][ni][4 * g + 1], acc[mi][ni][4 * g + 2], acc[mi][ni][4 * g + 3]);
                }
            }
        }
    }
}
DEV void merge_phase(const Params& p, int mtiles, bf16_t* lds) {
    const bf16_t* Y = (const bf16_t*)(p.ws + WS_Y);
    const bf16_t* Wb = (const bf16_t*)(p.ws + WS_W) + NW13 + NW2 + NWIN;
    const bf16_t* P = (const bf16_t*)(p.ws + WS_P);
    bf16_t* M = (bf16_t*)(p.ws + WS_XN);
    const int tid = TID(), lane = tid & 63, wave = tid >> 6, wr = wave >> 1, wc = wave & 1;
    const int ntiles = 16, tot = mtiles * ntiles;
    RegSet rp = {}, rq = {}; bool first = true;
    for (int t = blockIdx.x; t < tot; t += gridDim.x) {
        int mt, nt; tile_of(t, mtiles, ntiles, mt, nt);
        const bool hasn = t + (int)gridDim.x < tot; int mt2 = 0, nt2 = 0; if (hasn) tile_of(t + gridDim.x, mtiles, ntiles, mt2, nt2);
        f32x16 out[2][1]; zero_acc<1>(out);
#pragma unroll 1
        for (int j = 0; j < 3; j++) {
            f32x16 acc[2][1]; zero_acc<1>(acc);
            const int jn = j < 2 ? j + 1 : 0, mtn = j < 2 ? mt : mt2, ntn = j < 2 ? nt : nt2;
            const bool hn = j < 2 || hasn;
            gemm_kloop<1, 8>(acc, Y + (size_t)j * NTOK * 512 + (size_t)mt * 128 * 512, 512, Wb + (size_t)j * 1024 * 512 + (size_t)nt * 64 * 512, 512, 512, lds,
                          hn ? Y + (size_t)jn * NTOK * 512 + (size_t)mtn * 128 * 512 : nullptr, hn ? Wb + (size_t)jn * 1024 * 512 + (size_t)ntn * 64 * 512 : nullptr, 512, 512, first, rp, rq);
            first = false;
#pragma unroll
            for (int mi = 0; mi < 2; mi++) {
                const int row = mt * 128 + wr * 64 + mi * 32 + (lane & 31);
#pragma unroll
                for (int g = 0; g < 4; g++) {
                    const int col = nt * 64 + wc * 32 + 8 * g + 4 * (lane >> 5);
                    const uint2 gv = *(const uint2*)(P + (size_t)row * PW + C_BRG + j * 1024 + col);
                    out[mi][0][4 * g + 0] += sigm(bf2f(gv.x & 0xffffu)) * acc[mi][0][4 * g + 0];
                    out[mi][0][4 * g + 1] += sigm(bf2f(gv.x >> 16)) * acc[mi][0][4 * g + 1];
                    out[mi][0][4 * g + 2] += sigm(bf2f(gv.y & 0xffffu)) * acc[mi][0][4 * g + 2];
                    out[mi][0][4 * g + 3] += sigm(bf2f(gv.y >> 16)) * acc[mi][0][4 * g + 3];
                }
            }
        }
#pragma unroll
        for (int mi = 0; mi < 2; mi++) {
            const int row = mt * 128 + wr * 64 + mi * 32 + (lane & 31);
#pragma unroll
            for (int g = 0; g < 4; g++) {
                const int col = nt * 64 + wc * 32 + 8 * g + 4 * (lane >> 5);
                uint2 o; o.x = pack2(out[mi][0][4 * g], out[mi][0][4 * g + 1]); o.y = pack2(out[mi][0][4 * g + 2], out[mi][0][4 * g + 3]);
                *(uint2*)(M + (size_t)row * D + col) = o;
            }
        }
    }
}

DEV void attprep_job(const Params& p, int l, int job) {
    const bf16_t* P = (const bf16_t*)(p.ws + WS_P);
    bf16_t* Qa = (bf16_t*)(p.ws + WS_QA);
    bf16_t* Ka = (bf16_t*)(p.ws + WS_KA);
    const int lane = TID() & 63, wave = TID() >> 6;
    const float gq = p.qn_g[l * 64 + lane], gk = p.kn_g[l * 64 + lane];
    const float inv = exp2f(-(float)(lane & 15) * (13.287712379549449f / 16.f));
    for (int i = 0; i < 8; i++) {
        const int r = job * 32 + wave * 8 + i;
        float cs = 1.f, sn = 0.f;
        if (r < NLAT) { const int tk = r & (SEQ - 1); const float pos = (lane < 32) ? (float)(tk >> 6) : (float)(tk & 63); const float ang = pos * inv; cs = __cosf(ang); sn = __sinf(ang); }
        const float sgn = (lane & 16) ? 1.f : -1.f;
        for (int hd = 0; hd < 10; hd++) {
            const float xv = bf2f(P[(size_t)r * PW + C_ATQ + hd * 64 + lane]);
            const float ss = wave_sum(xv * xv);
            float y = xv * rsqrtf(ss * (1.f / 64.f) + EPS) * (hd < 8 ? gq : gk);
            const float yp = __shfl_xor(y, 16);
            y = y * cs + sgn * yp * sn;
#ifdef NAT
            if (hd < 8) Qa[(size_t)r * 512 + hd * 64 + lane] = f2bf(y * 0.125f) & 0xfffe;
            else Ka[(size_t)r * 128 + (hd - 8) * 64 + lane] = f2bf(y) & 0xfffe;
#else
            if (hd < 8) Qa[(size_t)r * 512 + hd * 64 + lane] = f2bf(y * 0.125f);
            else Ka[(size_t)r * 128 + (hd - 8) * 64 + lane] = f2bf(y);
#endif
        }
    }
}

DEV void att_job(const Params& p, int l, int b, int qb, int h, bf16_t* lds) {
    const bf16_t* P = (const bf16_t*)(p.ws + WS_P);
    const bf16_t* Qa = (const bf16_t*)(p.ws + WS_QA);
    const bf16_t* Ka = (const bf16_t*)(p.ws + WS_KA);
    bf16_t* Yc = (bf16_t*)(p.ws + WS_Y) + (size_t)2 * NTOK * 512;
    const int tid = TID(), lane = tid & 63, wave = tid >> 6;
    bf16_t* Ks = lds;
    bf16_t* Vt = lds + 128 * 72;
    bf16_t* Pw = Vt + 64 * 136;
    const int kvh = h >> 2;
    const int Rq = qb < 16 ? b * SEQ + qb * 128 : NLAT + b * CTX + (qb - 16) * 128;
#ifdef ATT_COPY
    for (int i = tid; i < 128 * 64; i += 256) { const int r = i >> 6, c = i & 63; Yc[(size_t)(Rq + r) * 512 + h * 64 + c] = Qa[(size_t)(Rq + r) * 512 + h * 64 + c]; }
    return;
#endif
    __syncthreads();
    load_tile<64>(Pw, 72, Qa + (size_t)Rq * 512 + h * 64, 512);
    __syncthreads();
    bf16x8 qf[4];
#pragma unroll
    for (int ks = 0; ks < 4; ks++) qf[ks] = *(const bf16x8*)(Pw + (wave * 32 + (lane & 31)) * 72 + ks * 16 + (lane >> 5) * 8);
    const float sink = p.sink[l * 8 + h];
    float mrun[16], lrun[16];
    f32x16 o[2];
#pragma unroll
    for (int r = 0; r < 16; r++) { mrun[r] = sink; lrun[r] = 0.f; o[0][r] = 0.f; o[1][r] = 0.f; }
    for (int kt = 0; kt < 5; kt++) {
        int Rk, mode = 0;
        if (kt < 3) {
            if (qb >= 16) continue;
            const int nb = qb - 1 + kt;
            if (nb < 0 || nb >= 16) continue;
            Rk = b * SEQ + nb * 128; mode = kt == 0 ? 1 : (kt == 2 ? 2 : 0);
        } else Rk = NLAT + b * CTX + (kt - 3) * 128;
        __syncthreads();
        load_tile<64>(Ks, 72, Ka + (size_t)Rk * 128 + kvh * 64, 128);
        load_tile_TP<64>(Vt, 136, P + (size_t)Rk * PW + C_ATV + kvh * 64, PW);
        __syncthreads();
        f32x16 s[4];
#pragma unroll
        for (int n = 0; n < 4; n++)
#pragma unroll
            for (int r = 0; r < 16; r++) s[n][r] = 0.f;
        wave_mma_reg<4, 4>(s, qf, Ks, 72, lane);
#pragma unroll
        for (int r = 0; r < 16; r++) {
            const int qi = wave * 32 + acc_row(r, lane);
            float mx = -3.0e38f;
#pragma unroll
            for (int n = 0; n < 4; n++) {
                const int ki = n * 32 + (lane & 31);
#if 1
                const int dpos = (kt < 3) ? ((qb - 1 + kt) * 128 + ki) - (qb * 128 + qi) : 0;
                const bool ok = dpos <= 128 && dpos >= -128;
#else
                const bool ok = mode == 0 || (mode == 1 ? ki >= qi : ki <= qi);
#endif
                const float v = ok ? s[n][r] : -1e30f;
                s[n][r] = v; mx = fmaxf(mx, v);
            }
#pragma unroll
            for (int off = 16; off > 0; off >>= 1) mx = fmaxf(mx, __shfl_xor(mx, off));
            const float mnew = fmaxf(mrun[r], mx);
            const float alpha = __expf(mrun[r] - mnew);
            mrun[r] = mnew;
            float ps = 0.f, pv[4];
#pragma unroll
            for (int n = 0; n < 4; n++) { pv[n] = __expf(s[n][r] - mnew); ps += pv[n]; }
            { uint2 w; w.x = pack2(pv[0], pv[1]); w.y = pack2(pv[2], pv[3]);
#ifdef NAT
              w.x &= 0xfffefffeu; w.y &= 0xfffefffeu;
#endif
              *(uint2*)(Pw + (wave * 32 + acc_row(r, lane)) * 136 + 4 * (lane & 31)) = w; }
            lrun[r] = lrun[r] * alpha + ps;
            o[0][r] *= alpha; o[1][r] *= alpha;
        }
        __syncthreads();
        wave_mma_lds<2>(o, Pw + wave * 32 * 136, 136, Vt, 136, 128, lane);
    }
#pragma unroll
    for (int r = 0; r < 16; r++) {
        float ls = lrun[r];
#pragma unroll
        for (int off = 16; off > 0; off >>= 1) ls += __shfl_xor(ls, off);
        ls += __expf(sink - mrun[r]);
        const float inv = 1.f / ls;
        const int row = Rq + wave * 32 + acc_row(r, lane);
#ifdef ATT_T1
        Yc[(size_t)row * 512 + h * 64 + (lane & 31)] = f2bf(inv);
        Yc[(size_t)row * 512 + h * 64 + 32 + (lane & 31)] = f2bf(mrun[r]);
#elif defined(ATT_T2)
        Yc[(size_t)row * 512 + h * 64 + (lane & 31)] = f2bf(o[0][r]);
        Yc[(size_t)row * 512 + h * 64 + 32 + (lane & 31)] = f2bf(o[1][r]);
#else
#ifdef ATT_ZERO_EDGE
        const float zz = (qb == 0 || qb == 15) ? 0.f : 1.f;
#elif defined(ATT_ZERO_MID)
        const float zz = (qb == 5 || qb == 10) ? 0.f : 1.f;
#else
        const float zz = 1.f;
#endif
        Yc[(size_t)row * 512 + h * 64 + (lane & 31)] = f2bf(o[0][r] * inv * zz);
        Yc[(size_t)row * 512 + h * 64 + 32 + (lane & 31)] = f2bf(o[1][r] * inv * zz);
#endif
    }
}


DEV void att_naive_job(const Params& p, int l, int job, int nrows) {
    const bf16_t* P = (const bf16_t*)(p.ws + WS_P);
    const bf16_t* Qa = (const bf16_t*)(p.ws + WS_QA);
    const bf16_t* Ka = (const bf16_t*)(p.ws + WS_KA);
    bf16_t* Yc = (bf16_t*)(p.ws + WS_Y) + (size_t)2 * NTOK * 512;
    const int gid = job * 256 + TID();
    const int R = gid >> 3, h = gid & 7, kvh = h >> 2;
    if (R >= nrows) return;
#ifdef NAIVE_CTX_ONLY
    if (R < NLAT) return;
#endif
#ifdef NAIVE_LAT_ONLY
    if (R >= NLAT) return;
#endif
    float q[64], o[64];
#pragma unroll
    for (int d = 0; d < 64; d++) { q[d] = bf2f(Qa[(size_t)R * 512 + h * 64 + d]); o[d] = 0.f; }
    float m = p.sink[l * 8 + h], lsum = 1.f;
    const bool lat = R < NLAT;
    const int b = lat ? (R >> 11) : ((R - NLAT) >> 8);
    const int t = lat ? (R & 2047) : 0;
    const int nband = lat ? 257 : 0;
    for (int kk = 0; kk < nband + 256; kk++) {
        int Rk;
        if (kk < nband) { const int tk = t - 128 + kk; if (tk < 0 || tk >= SEQ) continue; Rk = b * SEQ + tk; }
        else Rk = NLAT + b * CTX + (kk - nband);
        float sdot = 0.f;
#pragma unroll
        for (int d = 0; d < 64; d++) sdot += q[d] * bf2f(Ka[(size_t)Rk * 128 + kvh * 64 + d]);
        const float mn = fmaxf(m, sdot), al = expf(m - mn), pe = expf(sdot - mn);
        lsum = lsum * al + pe; m = mn;
#pragma unroll
        for (int d = 0; d < 64; d++) o[d] = o[d] * al + pe * bf2f(P[(size_t)Rk * PW + C_ATV + kvh * 64 + d]);
    }
    const float inv = 1.f / lsum;
#pragma unroll
    for (int d = 0; d < 64; d++) Yc[(size_t)R * 512 + h * 64 + d] = f2bf(o[d] * inv);
}
DEV void rg_coeffs(const Params& p, int l, int b, int q, int n, int dir, unsigned char* ldsb) {
    const bf16_t* P = (const bf16_t*)(p.ws + WS_P);
    const int tid = TID(), lane = tid & 63, wave = tid >> 6;
    bf16_t* u16 = (bf16_t*)ldsb;
    bf16_t* wt = u16 + 128 * 72;
    float* a32 = (float*)ldsb;
    float* ub32 = (float*)(ldsb + 36864);
    __syncthreads();
    {
        const int c8 = (tid & 7) * 8, cbase = n * 64 + c8;
        const int seqbase = q < 2 ? NLAT + b * CTX : b * SEQ, ts0 = q < 2 ? q * 128 : (q - 2) * 128, Ls = q < 2 ? CTX : SEQ;
        float cw[4][8], cb[8];
#pragma unroll
        for (int j = 0; j < 8; j++) { cb[j] = p.conv_b[l * 512 + cbase + j];
#pragma unroll
            for (int k = 0; k < 4; k++) cw[k][j] = p.conv_w[(l * 4 + k) * 512 + cbase + j]; }
        for (int ps = 0; ps < 4; ps++) {
            const int t = (tid >> 3) + 32 * ps;
            float a[8];
#pragma unroll
            for (int j = 0; j < 8; j++) a[j] = cb[j];
#pragma unroll
            for (int k = 0; k < 4; k++) {
                const int ts = ts0 + t + k - 2;
                if (ts >= 0 && ts < Ls) {
                    const uint4 v = *(const uint4*)(P + (size_t)(seqbase + ts) * PW + C_RGX + cbase);
                    const unsigned w[4] = {v.x, v.y, v.z, v.w};
#pragma unroll
                    for (int j = 0; j < 8; j++) a[j] += cw[k][j] * bf2f((w[j >> 1] >> (16 * (j & 1))) & 0xffffu);
                }
            }
            *(float4*)(ub32 + t * 64 + c8) = make_float4(a[0], a[1], a[2], a[3]);
            *(float4*)(ub32 + t * 64 + c8 + 4) = make_float4(a[4], a[5], a[6], a[7]);
            uint4 o; o.x = pack2(a[0], a[1]); o.y = pack2(a[2], a[3]); o.z = pack2(a[4], a[5]); o.w = pack2(a[6], a[7]);
#ifdef NRG
            o.x &= 0xfffefffeu; o.y &= 0xfffefffeu; o.z &= 0xfffefffeu; o.w &= 0xfffefffeu;
#endif
            *(uint4*)(u16 + t * 72 + c8) = o;
        }
        const float* wa = p.wa + (size_t)((l * 2 + dir) * 8 + n) * 4096;
        const float* wi = p.wi + (size_t)((l * 2 + dir) * 8 + n) * 4096;
        const int j = tid & 63;
#pragma unroll 4
        for (int it = 0; it < 8; it++) {
            const int i = 2 * ((tid >> 6) + 4 * it);
            *(unsigned*)(wt + j * 72 + i) = pack2(wa[i * 64 + j], wa[(i + 1) * 64 + j]);
            *(unsigned*)(wt + (64 + j) * 72 + i) = pack2(wi[i * 64 + j], wi[(i + 1) * 64 + j]);
        }
    }
    __syncthreads();
    f32x16 acc[4];
#pragma unroll
    for (int nn = 0; nn < 4; nn++)
#pragma unroll
        for (int r = 0; r < 16; r++) acc[nn][r] = 0.f;
    wave_mma_lds<4>(acc, u16 + wave * 32 * 72, 72, wt, 72, 64, lane);
    __syncthreads();
#pragma unroll
    for (int c2 = 0; c2 < 2; c2++) {
        const int ch = c2 * 32 + (lane & 31), c = n * 64 + ch;
        const float lam = p.lam[(l * 2 + dir) * 512 + c];
        const float cl = 8.f * log1pf(__expf(-lam));
        const float ba = p.ba[(l * 2 + dir) * 512 + c], bi = p.bi[(l * 2 + dir) * 512 + c];
#pragma unroll
        for (int r = 0; r < 16; r++) {
            const int t = wave * 32 + acc_row(r, lane);
            const float rr = sigm(acc[c2][r] + ba), ii = sigm(acc[2 + c2][r] + bi);
            const float la = -cl * rr;
            const float av = __expf(la);
            const float bv = sqrtf(-expm1f(2.f * la)) * ii * ub32[t * 64 + ch];
            a32[t * 64 + ch] = av;
            ub32[t * 64 + ch] = bv;
        }
    }
    __syncthreads();
}
DEV void rg_r1_job(const Params& p, int l, int item, unsigned char* ldsb) {
    const int dir = item & 1, n = (item >> 1) & 7, bq = item >> 4, q = bq % 18, b = bq / 18;
    rg_coeffs(p, l, b, q, n, dir, ldsb);
    const float* a32 = (const float*)ldsb;
    const float* b32 = (const float*)(ldsb + 36864);
    float* segP = (float*)(ldsb + 69632);
    float* segH = segP + 256;
    const int tid = TID(), ch = tid & 63, seg = tid >> 6;
    const int tseg = dir ? 3 - seg : seg;
    float Pp = 1.f, hh = 0.f;
#pragma unroll 8
    for (int i = 0; i < 32; i++) { const int t = seg * 32 + (dir ? 31 - i : i); const float a = a32[t * 64 + ch]; hh = a * hh + b32[t * 64 + ch]; Pp *= a; }
    segP[tseg * 64 + ch] = Pp; segH[tseg * 64 + ch] = hh;
    __syncthreads();
    if (seg == 0) {
        float PP = 1.f, H = 0.f;
#pragma unroll
        for (int k = 0; k < 4; k++) { H = segP[k * 64 + ch] * H + segH[k * 64 + ch]; PP *= segP[k * 64 + ch]; }
        float2* rgs = (float2*)(p.ws + WS_RGS);
        rgs[(size_t)((b * 2 + dir) * 18 + q) * 512 + n * 64 + ch] = make_float2(PP, H);
    }
}
DEV void rg_r2_job(const Params& p, int l, int b, int q, int n, unsigned char* ldsb) {
    const bf16_t* P = (const bf16_t*)(p.ws + WS_P);
    bf16_t* Ya = (bf16_t*)(p.ws + WS_Y);
    const float2* rgs = (const float2*)(p.ws + WS_RGS);
    const float* a32 = (const float*)ldsb;
    const float* b32 = (const float*)(ldsb + 36864);
    float* segP = (float*)(ldsb + 69632);
    float* segH = segP + 256;
    const int tid = TID(), ch = tid & 63, seg = tid >> 6, c = n * 64 + ch;
    const int R0 = chunk_row(b, q);
    float hf[32];
#pragma unroll
    for (int dir = 0; dir < 2; dir++) {
        rg_coeffs(p, l, b, q, n, dir, ldsb);
        const int pos = dir ? (q < 2 ? 1 - q : 19 - q) : q;
        float hc = 0.f;
        for (int k = 0; k < pos; k++) { const int qq = dir ? (k < 2 ? 1 - k : 19 - k) : k; const float2 v = rgs[(size_t)((b * 2 + dir) * 18 + qq) * 512 + c]; hc = v.x * hc + v.y; }
        const int tseg = dir ? 3 - seg : seg;
        float Pp = 1.f, hh = 0.f;
#pragma unroll 8
        for (int i = 0; i < 32; i++) { const int t = seg * 32 + (dir ? 31 - i : i); const float a = a32[t * 64 + ch]; hh = a * hh + b32[t * 64 + ch]; Pp *= a; }
        segP[tseg * 64 + ch] = Pp; segH[tseg * 64 + ch] = hh;
        __syncthreads();
        float hs = hc;
        for (int k = 0; k < tseg; k++) hs = segP[k * 64 + ch] * hs + segH[k * 64 + ch];
        if (dir == 0) {
#pragma unroll
            for (int i = 0; i < 32; i++) { const int t = seg * 32 + i; hs = a32[t * 64 + ch] * hs + b32[t * 64 + ch]; hf[i] = hs; }
        } else {
#pragma unroll
            for (int i = 0; i < 32; i++) {
                const int jj = 31 - i, t = seg * 32 + jj;
                hs = a32[t * 64 + ch] * hs + b32[t * 64 + ch];
                const float g = bf2f(P[(size_t)(R0 + t) * PW + C_RGG + c]);
#ifdef NY
                Ya[(size_t)(R0 + t) * 512 + c] = f2bf((hf[jj] + hs) * gelu_tanh(g)) & 0xfffe;
#else
                Ya[(size_t)(R0 + t) * 512 + c] = f2bf((hf[jj] + hs) * gelu_tanh(g));
#endif
            }
        }
    }
}

DEV float log_sigmoid(float x) { return fminf(x, 0.f) - log1pf(__expf(-fabsf(x))); }
DEV void ml_m1_job(const Params& p, int l, int item, bf16_t* lds) {
    const bf16_t* P = (const bf16_t*)(p.ws + WS_P);
    const float* G = (const float*)(p.ws + WS_G);
    const int tid = TID(), lane = tid & 63, wave = tid >> 6;
    const int q = item % 18, chain = item / 18, dir = chain & 1, h = (chain >> 1) & 3, b = chain >> 3;
    const int R0 = chunk_row(b, q);
    bf16_t* As = lds;
    bf16_t* Bs = lds + 128 * 136;
    float* sm = (float*)(lds + 2 * 128 * 136);
    float* ig = sm; float* fl = sm + 128; float* we = sm + 256; float* wv = sm + 384; float* misc = sm + 512;
    __syncthreads();
    if (tid < 128) {
        ig[tid] = G[(size_t)(R0 + tid) * 16 + (2 * dir) * 4 + h] + p.gate_b[l * 16 + (2 * dir) * 4 + h];
        fl[tid] = log_sigmoid(G[(size_t)(R0 + tid) * 16 + (2 * dir + 1) * 4 + h] + p.gate_b[l * 16 + (2 * dir + 1) * 4 + h]);
    }
    __syncthreads();
    if (wave == 0) {
        const int p0 = 2 * lane, s0 = dir ? 127 - p0 : p0, s1 = dir ? 126 - p0 : p0 + 1;
        const float f0 = fl[s0], f1 = fl[s1], c1 = f0 + f1;
        const float sc = wave_scan_add(c1, lane), tot = __shfl(sc, 63), off = sc - c1;
        const float w0 = tot - (off + f0) + ig[s0], w1 = tot - (off + c1) + ig[s1];
        we[s0] = w0; we[s1] = w1;
        const float mx = wave_max(fmaxf(w0, w1));
        if (lane == 0) { misc[0] = mx; misc[1] = tot; float* mls = (float*)(p.ws + WS_MLS); mls[item * 2] = mx; mls[item * 2 + 1] = tot; }
    }
    __syncthreads();
    if (tid < 128) wv[tid] = __expf(we[tid] - misc[0]);
    __syncthreads();
    load_tile_T<128>(As, 136, P + (size_t)R0 * PW + C_MLV + h * 128, PW, wv);
    load_tile_T<128>(Bs, 136, P + (size_t)R0 * PW + C_MLK + h * 128, PW, nullptr);
    __syncthreads();
    f32x16 acc[4];
#pragma unroll
    for (int n = 0; n < 4; n++)
#pragma unroll
        for (int r = 0; r < 16; r++) acc[n][r] = 0.f;
    wave_mma_lds<4>(acc, As + wave * 32 * 136, 136, Bs, 136, 128, lane);
    const float ksc = 0.08838834764831845f;
    float* dC = (float*)(p.ws + WS_DC) + (size_t)item * 16384;
#pragma unroll
    for (int n = 0; n < 4; n++)
#pragma unroll
        for (int r = 0; r < 16; r++) dC[(wave * 32 + acc_row(r, lane)) * 128 + n * 32 + (lane & 31)] = acc[n][r] * ksc;
    {
        const int dk = tid >> 1, hf = tid & 1;
        float s = 0.f;
        for (int i = 0; i < 64; i++) { const int ss = hf * 64 + i; s += bf2f(Bs[dk * 136 + ss]) * wv[ss]; }
        s += __shfl_xor(s, 1);
        if (hf == 0) ((float*)(p.ws + WS_DN))[(size_t)item * 128 + dk] = s * ksc;
    }
}
DEV void ml_m2_job(const Params& p, int item) {
    const int tid = TID(), slice = item & 15, chain = item >> 4, dir = chain & 1;
    const float* dC = (const float*)(p.ws + WS_DC);
    const float* dn = (const float*)(p.ws + WS_DN);
    const float* mls = (const float*)(p.ws + WS_MLS);
    bf16_t* Cin = (bf16_t*)(p.ws + WS_CIN);
    float* nin = (float*)(p.ws + WS_NIN);
    float* min_ = (float*)(p.ws + WS_MIN);
    const int e0 = slice * 1024 + tid * 4;
    float4 C = make_float4(0.f, 0.f, 0.f, 0.f);
    float nv = 0.f, m = 0.f;
    for (int k = 0; k < 18; k++) {
        const int q = dir ? (k < 2 ? 1 - k : 19 - k) : k;
        const int it = chain * 18 + q;
        uint2 o; o.x = pack2(C.x, C.y); o.y = pack2(C.z, C.w);
#ifdef NML
        o.x &= 0xfffefffeu; o.y &= 0xfffefffeu;
#endif
        *(uint2*)(Cin + (size_t)it * 16384 + e0) = o;
        if (slice == 0) { if (tid < 128) nin[(size_t)it * 128 + tid] = nv; if (tid == 0) min_[it] = m; }
        if (k == 17) break;
        const float mloc = mls[it * 2], bend = mls[it * 2 + 1];
        const float mnew = fmaxf(bend + m, mloc);
        const float d1 = __expf(bend + m - mnew), d2 = __expf(mloc - mnew);
        const float4 dc = *(const float4*)(dC + (size_t)it * 16384 + e0);
        C.x = d1 * C.x + d2 * dc.x; C.y = d1 * C.y + d2 * dc.y; C.z = d1 * C.z + d2 * dc.z; C.w = d1 * C.w + d2 * dc.w;
        if (slice == 0 && tid < 128) nv = d1 * nv + d2 * dn[(size_t)it * 128 + tid];
        m = mnew;
    }
}
DEV void ml_m3_job(const Params& p, int l, int b, int h, int q, bf16_t* lds) {
    const bf16_t* P = (const bf16_t*)(p.ws + WS_P);
    const float* G = (const float*)(p.ws + WS_G);
    const bf16_t* Cin = (const bf16_t*)(p.ws + WS_CIN);
    const float* nin = (const float*)(p.ws + WS_NIN);
    const float* min_ = (const float*)(p.ws + WS_MIN);
    bf16_t* Yb = (bf16_t*)(p.ws + WS_Y) + (size_t)NTOK * 512;
    const int tid = TID(), lane = tid & 63, wave = tid >> 6;
    const int R0 = chunk_row(b, q);
    bf16_t* Bs = lds;
    bf16_t* Pw = lds + 128 * 136;
    float* sm = (float*)(lds + 2 * 128 * 136);
    float* ig = sm; float* fl = sm + 128; float* acol = sm + 256; float* Mrow = sm + 384; float* brow = sm + 512; float* nl = sm + 640; float* qn = sm + 768; float* denl = sm + 896; float* decl = sm + 1024; float* bndl = sm + 1152;
    __syncthreads();
    load_tile<128>(Pw, 136, P + (size_t)R0 * PW + C_MLQ + h * 128, PW);
    __syncthreads();
    bf16x8 qf[8];
#pragma unroll
    for (int ks = 0; ks < 8; ks++) qf[ks] = *(const bf16x8*)(Pw + (wave * 32 + (lane & 31)) * 136 + ks * 16 + (lane >> 5) * 8);
    float* Ht = (float*)(p.ws + WS_XN);
    const float ksc = 0.08838834764831845f;
#pragma unroll 1
    for (int dir = 0; dir < 2; dir++) {
        const int it = ((b * 4 + h) * 2 + dir) * 18 + q;
        const float m_in = min_[it];
        __syncthreads();
        if (tid < 128) {
            ig[tid] = G[(size_t)(R0 + tid) * 16 + (2 * dir) * 4 + h] + p.gate_b[l * 16 + (2 * dir) * 4 + h];
            fl[tid] = log_sigmoid(G[(size_t)(R0 + tid) * 16 + (2 * dir + 1) * 4 + h] + p.gate_b[l * 16 + (2 * dir + 1) * 4 + h]);
            nl[tid] = nin[(size_t)it * 128 + tid];
        }
        load_tile<128>(Bs, 136, P + (size_t)R0 * PW + C_MLK + h * 128, PW);
        __syncthreads();
        if (wave == 0) {
            const int p0 = 2 * lane, s0 = dir ? 127 - p0 : p0, s1 = dir ? 126 - p0 : p0 + 1;
            const float f0 = fl[s0], f1 = fl[s1], c1 = f0 + f1;
            const float sc = wave_scan_add(c1, lane), off = sc - c1, b0 = off + f0, b1 = off + c1;
            const float a0 = ig[s0] - b0, a1 = ig[s1] - b1;
            const float sm = wave_scan_max(fmaxf(a0, a1), lane);
            float prev = __shfl_up(sm, 1); if (lane == 0) prev = -3.0e38f;
            const float pm0 = fmaxf(prev, a0);
            brow[s0] = b0; brow[s1] = b1; acol[s0] = a0; acol[s1] = a1;
            Mrow[s0] = fmaxf(m_in, pm0); Mrow[s1] = fmaxf(m_in, sm);
        }
        {
            float s = 0.f;
#pragma unroll
            for (int ks = 0; ks < 8; ks++)
#pragma unroll
                for (int j = 0; j < 8; j++) { s += bf2f((unsigned short)qf[ks][j]) * nl[ks * 16 + (lane >> 5) * 8 + j]; if (j == 7) __builtin_amdgcn_sched_barrier(0); }
            s += __shfl_xor(s, 32);
            if (lane < 32) qn[wave * 32 + lane] = s;
        }
        f32x16 s4[4];
#pragma unroll
        for (int n = 0; n < 4; n++)
#pragma unroll
            for (int r = 0; r < 16; r++) s4[n][r] = 0.f;
        wave_mma_reg<4, 8>(s4, qf, Bs, 136, lane);
        __syncthreads();
        const int lnA = OPQ(lane);
#pragma unroll
        for (int r = 0; r < 16; r++) {
            const int t = wave * 32 + acc_row(r, lnA);
            const float Mt = Mrow[t];
            float ps = 0.f, pv[4];
#pragma unroll
            for (int n = 0; n < 4; n++) {
                const int s = n * 32 + (lnA & 31);
                const bool ok = dir ? (s >= t) : (s <= t);
                pv[n] = ok ? s4[n][r] * ksc * __expf(acol[s] - Mt) : 0.f;
                ps += pv[n];
            }
            { uint2 w; w.x = pack2(pv[0], pv[1]); w.y = pack2(pv[2], pv[3]);
#ifdef NML
              w.x &= 0xfffefffeu; w.y &= 0xfffefffeu;
#endif
              *(uint2*)(Pw + t * 136 + 4 * (lnA & 31)) = w; }
#pragma unroll
            for (int off = 16; off > 0; off >>= 1) ps += __shfl_xor(ps, off);
            const float dc = __expf(m_in - Mt);
            if ((lnA & 31) == 0) { denl[t] = ps + dc * qn[t]; decl[t] = dc; bndl[t] = __expf(-(brow[t] + Mt)); }
            __builtin_amdgcn_sched_barrier(0);
        }
        load_tile<128>(Bs, 136, Cin + (size_t)it * 16384, 128);
        __syncthreads();
        f32x16 num[4];
#pragma unroll
        for (int n = 0; n < 4; n++)
#pragma unroll
            for (int r = 0; r < 16; r++) num[n][r] = 0.f;
        wave_mma_reg<4, 8>(num, qf, Bs, 136, lane);
        const int lnB = OPQ(lane);
#pragma unroll
        for (int r = 0; r < 16; r++) {
            const float dc = decl[wave * 32 + acc_row(r, lnB)];
#pragma unroll
            for (int n = 0; n < 4; n++) num[n][r] *= dc;
        }
        __syncthreads();
        load_tile_TP<128>(Bs, 136, P + (size_t)R0 * PW + C_MLV + h * 128, PW);
        __syncthreads();
        wave_mma_lds<4>(num, Pw + wave * 32 * 136, 136, Bs, 136, 128, lane);
        const int lnC = OPQ(lane);
        if (dir == 0) {
#pragma unroll
            for (int r = 0; r < 16; r++) {
                const int t = wave * 32 + acc_row(r, lnC);
                const float inv = 1.f / fmaxf(fabsf(denl[t]), bndl[t]);
#pragma unroll
                for (int n = 0; n < 4; n++) Ht[(size_t)(R0 + t) * 512 + h * 128 + n * 32 + (lnC & 31)] = num[n][r] * inv;
                __builtin_amdgcn_sched_barrier(0);
            }
        } else {
#pragma unroll
            for (int r = 0; r < 16; r++) {
                const int t = wave * 32 + acc_row(r, lnC);
                const float inv = 1.f / fmaxf(fabsf(denl[t]), bndl[t]);
                float hv[4], ss = 0.f;
#pragma unroll
                for (int n = 0; n < 4; n++) { hv[n] = num[n][r] * inv + Ht[(size_t)(R0 + t) * 512 + h * 128 + n * 32 + (lnC & 31)]; ss += hv[n] * hv[n]; }
#pragma unroll
                for (int off = 16; off > 0; off >>= 1) ss += __shfl_xor(ss, off);
                const float rstd = rsqrtf(ss * (1.f / 128.f) + EPS);
#pragma unroll
                for (int n = 0; n < 4; n++) {
                    const int cc = h * 128 + n * 32 + (lnC & 31);
                    const float og = sigm(bf2f(P[(size_t)(R0 + t) * PW + C_MLO + cc]));
#ifdef NML
                    Yb[(size_t)(R0 + t) * 512 + cc] = f2bf(hv[n] * rstd * p.ml_norm_g[l * 512 + cc] * og) & 0xfffe;
#else
                    Yb[(size_t)(R0 + t) * 512 + cc] = f2bf(hv[n] * rstd * p.ml_norm_g[l * 512 + cc] * og);
#endif
                }
                __builtin_amdgcn_sched_barrier(0);
            }
        }
    }
}

#define XB_TMO      128
#define XB_XCNT(j)  (256  + 64 * (j))
#define XB_XSUB(j)  (1280 + 64 * (j))
#define XB_XGEN(j)  (2304 + 64 * (j))
#define XB_TOP      3328
#define XB_TOPGEN   3392
#define XCD_BAR_WORDS 3456
#define XB_SPIN_CAP (1u << 22)
#define LAS __attribute__((address_space(3)))
DEV unsigned xb_ld(unsigned* p)              { return __hip_atomic_load(p, __ATOMIC_RELAXED, __HIP_MEMORY_SCOPE_AGENT); }
DEV unsigned xb_add(unsigned* p, unsigned v) { return __hip_atomic_fetch_add(p, v, __ATOMIC_RELAXED, __HIP_MEMORY_SCOPE_AGENT); }
DEV unsigned xb_xcc_id() { return (unsigned)__builtin_amdgcn_s_getreg((3 << 11) | 20) & 0xFu; }
#define XB_SPIN(cond, bar) do { unsigned _sp = 0; while (cond) { __builtin_amdgcn_s_sleep(1); \
    if ((++_sp & 255u) == 0u) { if (xb_ld(&(bar)[XB_TMO])) break; if (_sp > XB_SPIN_CAP) { atomicAdd(&(bar)[XB_TMO], 1u); break; } } } } while (0)
struct XcdBarrier { unsigned* bar; unsigned x; volatile LAS unsigned* st; };
DEV XcdBarrier xcd_barrier_post(unsigned* bar, volatile LAS unsigned* st) {
    XcdBarrier b; b.bar = bar; b.x = xb_xcc_id(); b.st = st;
    if (threadIdx.x == 0) (void)xb_add(&bar[XB_XCNT(b.x)], 1u);
    return b;
}
DEV void xcd_barrier_complete(unsigned* bar, unsigned x, unsigned& nloc, unsigned& nx) {
    const unsigned G = gridDim.x * gridDim.y * gridDim.z;
    unsigned sum, cnt, mine, sp = 0u;
    for (;;) {
        sum = 0u; cnt = 0u; mine = 0u;
#pragma unroll
        for (unsigned j = 0; j < 16; ++j) { const unsigned c = xb_ld(&bar[XB_XCNT(j)]); sum += c; cnt += (c > 0u) ? 1u : 0u; mine = (j == x) ? c : mine; }
        if (sum == G) break;
        __builtin_amdgcn_s_sleep(1);
        if ((++sp & 255u) == 0u) { if (xb_ld(&bar[XB_TMO])) break; if (sp > XB_SPIN_CAP) { atomicAdd(&bar[XB_TMO], 1u); break; } }
    }
    nloc = mine > 0u ? mine : 1u; nx = cnt > 0u ? cnt : 1u;
}
DEV void xcd_barrier(const XcdBarrier& b) {
    asm volatile("s_waitcnt vmcnt(0)" ::: "memory");
    __syncthreads();
    if (threadIdx.x == 0) {
        unsigned* bar = b.bar;
        __builtin_amdgcn_s_waitcnt(0);
        unsigned nloc = b.st[0], nx = b.st[1];
        if (nloc == 0u) { xcd_barrier_complete(bar, b.x, nloc, nx); b.st[0] = nloc; b.st[1] = nx; }
        const unsigned old = xb_add(&bar[XB_XSUB(b.x)], 1u);
        const unsigned gen = old / nloc;
        if (old + 1u == (gen + 1u) * nloc) {
            __builtin_amdgcn_fence(__ATOMIC_RELEASE, "agent");
            asm volatile("s_waitcnt vmcnt(0)" ::: "memory");
            const unsigned og = xb_add(&bar[XB_TOP], 1u);
            const unsigned tg = og / nx;
            if (og + 1u == (tg + 1u) * nx) xb_add(&bar[XB_TOPGEN], 1u);
            else XB_SPIN(xb_ld(&bar[XB_TOPGEN]) == tg, bar);
            __builtin_amdgcn_fence(__ATOMIC_ACQUIRE, "agent");
            xb_add(&bar[XB_XGEN(b.x)], 1u);
            asm volatile("s_waitcnt vmcnt(0)" ::: "memory");
        } else {
            XB_SPIN(xb_ld(&bar[XB_XGEN(b.x)]) == gen, bar);
            __builtin_amdgcn_fence(__ATOMIC_ACQUIRE, "agent");
            asm volatile("s_waitcnt vmcnt(0)" ::: "memory");
        }
    }
    __syncthreads();
}
DEV int next_job(unsigned* ctr, volatile unsigned* slot) {
    __syncthreads();
    if (threadIdx.x == 0) *slot = __hip_atomic_fetch_add(ctr, 1u, __ATOMIC_RELAXED, __HIP_MEMORY_SCOPE_AGENT);
    __syncthreads();
    return __builtin_amdgcn_readfirstlane((int)*slot);
}
__global__ void __launch_bounds__(256, 2) fwd_megakernel(Params p) {
    cg::grid_group grid = cg::this_grid();
    extern __shared__ __attribute__((aligned(16))) unsigned char ldsb[];
    bf16_t* lds = (bf16_t*)ldsb;
    const int G_ = gridDim.x, bid = blockIdx.x, tid = threadIdx.x;
    unsigned* bar = (unsigned*)(p.ws + WS_BAR);
    volatile LAS unsigned* xst = (volatile LAS unsigned*)(LAS unsigned char*)(ldsb + LDS_BYTES - 16);
    volatile unsigned* jslot = (volatile unsigned*)(ldsb + LDS_BYTES - 8);
    if (tid == 0) { xst[0] = 0u; xst[1] = 0u; }
    __syncthreads();
    const XcdBarrier xb = xcd_barrier_post(bar, xst);
    if (p.ws == nullptr) grid.sync();
#ifdef REP_BAR
#define GS() do { xcd_barrier(xb); xcd_barrier(xb); } while (0)
#else
#define GS() xcd_barrier(xb)
#endif

    {
        for (int j = bid; j < 576 + NWJOBS; j += G_) { if (j < 576) { PH(1) ada_job(p, j, (float*)ldsb); } else { PH(1) wconv_job(p, 0, j - 576, lds); } }
        float4* X4 = (float4*)(p.ws + WS_X);
        const float4* x4 = (const float4*)p.x; const float4* c4 = (const float4*)p.ctx;
        const size_t nl4 = (size_t)NLAT * D / 4, nt4 = (size_t)NTOK * D / 4;
        for (size_t i = (size_t)bid * 256 + tid; i < nt4; i += (size_t)G_ * 256) X4[i] = i < nl4 ? x4[i] : c4[i - nl4];
    }
    GS();
    const bf16_t* W = (const bf16_t*)(p.ws + WS_W);
    for (int l = 0; l < DEPTH; l++) {
        const bool ctx_out = l < DEPTH - 1;
        const int mt_all = 144, mt_late = ctx_out ? 144 : 128;
        if (l > 0) { for (int rep = 0; rep < REP_NORM; rep++) for (int j = bid; j < NWJOBS; j += G_) wconv_job(p, l, j, lds); }
        for (int rep = 0; rep < REP_NORM; rep++) { PH(2) norm_phase(p, l, 0, NTOK); }
        GS();
        for (int rep = 0; rep < REP_GEMM; rep++) { PH(4) ffn_up_phase(p, 0, mt_all, lds); }
        GS();
        PH(8) resid_gemm_phase<44>(p, l, (const bf16_t*)(p.ws + WS_U), DFF, W + NW13, 2, 0.5f, mt_all, lds);
        GS();
#ifndef SKIP_MIX
        for (int rep = 0; rep < REP_NORM; rep++) norm_phase(p, l, 1, NTOK);
        GS();
        for (int rep = 0; rep < REP_GEMM; rep++) { PH(16) win_phase(p, !ctx_out, lds); }
        GS();
        for (int rep = 0; rep < REP_MIX1; rep++)
        for (int j = bid; j < 1152 + 2304 + 576; j += G_) {
            if (j < 1152) { MX(1) ml_m1_job(p, l, j, lds); }
            else if (j < 3456) { MX(2) rg_r1_job(p, l, j - 1152, ldsb); }
            else { MX(4) attprep_job(p, l, j - 3456); }
        }
        GS();
        {
            const int q0 = ctx_out ? 0 : 2, nq = 18 - q0;
            const int natt = NB * (ctx_out ? 18 : 16) * 8, nr2 = NB * nq * 8;
            for (int rep = 0; rep < REP_MIX2; rep++)
            for (int j = next_job(bar + (l * 4 + 1) * 8, jslot); j < 1024 + natt; j = next_job(bar + (l * 4 + 1) * 8, jslot)) {
                if (j < 1024) { MX(1) ml_m2_job(p, j); }
                else { int i = j - 1024; const int h = i & 7; i >>= 3; const int nqb = ctx_out ? 18 : 16; MX(4) att_job(p, l, i / nqb, i % nqb, h, lds); }
            }
            GS();
#ifdef ATT_NAIVE
            { const int nrows = ctx_out ? NTOK : NLAT; for (int j = bid; j < (nrows * 8 + 255) / 256; j += G_) att_naive_job(p, l, j, nrows); }
#endif
            for (int rep = 0; rep < REP_MIX3; rep++)
            for (int j = next_job(bar + (l * 4 + 2) * 8, jslot); j < NB * 4 * nq + nr2; j = next_job(bar + (l * 4 + 2) * 8, jslot)) {
                if (j < NB * 4 * nq) { const int q = q0 + j % nq, bh = j / nq; MX(1) ml_m3_job(p, l, bh >> 2, bh & 3, q, lds); }
                else { int i = j - NB * 4 * nq; const int n = i & 7; i >>= 3; MX(2) rg_r2_job(p, l, i / nq, q0 + i % nq, n, ldsb); }
            }
        }
        GS();
        for (int rep = 0; rep < REP_GEMM; rep++) { PH(4096) merge_phase(p, mt_late, lds); }
        GS();
        resid_gemm_phase<16>(p, l, (const bf16_t*)(p.ws + WS_XN), D, W + NW13 + NW2 + NWIN + NWB, 5, 1.0f, mt_late, lds);
        GS();
#endif
        for (int rep = 0; rep < REP_NORM; rep++) norm_phase(p, l, 2, mt_late * 128);
        GS();
        for (int rep = 0; rep < REP_GEMM; rep++) ffn_up_phase(p, 1, mt_late, lds);
        GS();
        resid_gemm_phase<44>(p, l, (const bf16_t*)(p.ws + WS_U), DFF, W + NW13 + NW2 / 2, 8, 0.5f, mt_late, lds, ctx_out ? nullptr : p.out);
        if (ctx_out) GS();
    }
}

extern "C" void kernel_launch(void* const* d_in, const int* in_sizes, int n_in, void* d_out, int out_size, void* d_ws, size_t ws_size, hipStream_t stream) {
    static int grid_blocks = 0;
    if (!grid_blocks) {
        int dev = 0, cus = 0, per_cu = 0;
        hipGetDevice(&dev);
        hipDeviceGetAttribute(&cus, hipDeviceAttributeMultiprocessorCount, dev);
        hipFuncSetAttribute((const void*)fwd_megakernel, hipFuncAttributeMaxDynamicSharedMemorySize, LDS_BYTES);
        hipOccupancyMaxActiveBlocksPerMultiprocessor(&per_cu, fwd_megakernel, 256, LDS_BYTES);
        if (per_cu < 1) per_cu = 1;
        if (per_cu > 2) per_cu = 2;
        grid_blocks = cus * per_cu;
        if (ws_size < WS_END) fprintf(stderr, "workspace too small: %zu < %zu\n", ws_size, (size_t)WS_END);
    }
    Params p{};
    const float** f = (const float**)&p;
    for (int i = 0; i < 25; i++) f[i] = (const float*)d_in[i];
    p.out = (float*)d_out;
    p.ws = (unsigned char*)d_ws;
    hipMemsetAsync((char*)d_ws + WS_BAR, 0, 13824, stream);
    void* args[] = {&p};
    hipError_t e = hipLaunchCooperativeKernel((void*)fwd_megakernel, dim3(grid_blocks), dim3(256), args, LDS_BYTES, stream);
    if (e != hipSuccess) fprintf(stderr, "cooperative launch failed: %s (grid %d)\n", hipGetErrorString(e), grid_blocks);
}
```

```cpp
#include <hip/hip_runtime.h>
#include <hip/hip_cooperative_groups.h>
#include <cstdio>
#include <cstdint>
namespace cg = cooperative_groups;

typedef unsigned short bf16_t;
typedef short bf16x8 __attribute__((ext_vector_type(8)));
typedef float f32x16 __attribute__((ext_vector_type(16)));
#define DEV __device__ __forceinline__
DEV int OPQ(int v) { asm volatile("" : "+v"(v)); return v; }
DEV int TID() { int t = threadIdx.x; asm volatile("" : "+v"(t)); return t; }

constexpr int D = 1024, NB = 8, SEQ = 2048, CTX = 256, DEPTH = 4, DFF = 2816;
constexpr int NLAT = NB * SEQ, NTOK = NLAT + NB * CTX;
constexpr int DIN = 6928, PW = 6912, NIN = 7040;
constexpr int NMODC = 9 * D;
constexpr int C_RGX = 0, C_RGG = 512, C_MLQ = 1024, C_MLK = 1536, C_MLV = 2048, C_MLO = 2560, C_ATQ = 3072, C_ATK = 3584, C_ATV = 3712, C_BRG = 3840;
constexpr float EPS = 1e-6f;

constexpr size_t al256(size_t x) { return (x + 255) & ~(size_t)255; }
constexpr size_t WS_X = 0;
constexpr size_t WS_XN = WS_X + al256((size_t)NTOK * D * 4);
constexpr size_t WS_U = WS_XN + al256((size_t)NTOK * D * 2);
constexpr size_t WS_P = WS_U + al256((size_t)NTOK * DFF * 2);
constexpr size_t WS_G = WS_P + al256((size_t)NTOK * PW * 2);
constexpr size_t NW13 = (size_t)2 * 5632 * 1024, NW2 = (size_t)2 * 1024 * 2816, NWIN = (size_t)NIN * 1024, NWB = (size_t)3 * 1024 * 512, NWO = (size_t)1024 * 1024;
constexpr size_t WS_W = WS_G + al256((size_t)NTOK * 16 * 4);
constexpr size_t WS_Y = WS_W + al256((NW13 + NW2 + NWIN + NWB + NWO) * 2);
constexpr size_t WS_CIN = WS_Y + al256((size_t)3 * NTOK * 512 * 2);
constexpr size_t WS_MOD = WS_CIN + al256((size_t)64 * 18 * 16384 * 2);
constexpr size_t WS_DN = WS_MOD + al256((size_t)DEPTH * NMODC * 9 * 4);
constexpr size_t WS_MLS = WS_DN + al256((size_t)1152 * 128 * 4);
constexpr size_t WS_NIN = WS_MLS + al256((size_t)1152 * 2 * 4);
constexpr size_t WS_MIN = WS_NIN + al256((size_t)1152 * 128 * 4);
constexpr size_t WS_RGS = WS_MIN + al256((size_t)1152 * 4);
constexpr size_t WS_BAR = WS_RGS + al256((size_t)NB * 2 * 18 * 512 * 2 * 4);
constexpr size_t WS_END = WS_BAR + 13824;
constexpr size_t WS_DC = WS_U;
constexpr size_t WS_QA = WS_DC + al256((size_t)1152 * 16384 * 4);
constexpr size_t WS_KA = WS_QA + al256((size_t)NTOK * 512 * 2);
static_assert(WS_KA + (size_t)NTOK * 128 * 2 <= WS_P, "overlay overflow");

constexpr int LDS_BYTES = 80 * 1024;
#ifndef REP_GEMM
#define REP_GEMM 1
#endif
#ifndef REP_MIX1
#define REP_MIX1 1
#endif
#ifndef REP_MIX2
#define REP_MIX2 1
#endif
#ifndef REP_MIX3
#define REP_MIX3 1
#endif
#ifndef REP_NORM
#define REP_NORM 1
#endif
#ifndef PHMASK
#define PHMASK 0xffff
#endif
#define PH(x) if ((PHMASK) & (x))
#ifndef MIXMASK
#define MIXMASK 7
#endif
#define MX(x) if ((MIXMASK) & (x))

struct Params {
    const float *x, *c, *ctx, *c_ctx, *ada_w, *ada_b, *norm_g, *w1, *w3, *w2, *w_in, *conv_w, *conv_b, *wa, *ba, *wi, *bi, *lam,
        *gate_b, *ml_norm_g, *qn_g, *kn_g, *sink, *w_branch, *w_out;
    float* out;
    unsigned char* ws;
};

DEV float bf2f(unsigned h) { return __uint_as_float(h << 16); }
typedef float f32x2_t __attribute__((ext_vector_type(2)));
typedef __bf16 bf16x2_t __attribute__((ext_vector_type(2)));
DEV unsigned pack2(float lo, float hi) { f32x2_t v = {lo, hi}; bf16x2_t b = __builtin_convertvector(v, bf16x2_t);
#ifdef NOISY
    return __builtin_bit_cast(unsigned, b) & 0xfffefffeu; }
#else
    return __builtin_bit_cast(unsigned, b); }
#endif
DEV bf16_t f2bf(float f) { return (bf16_t)(pack2(f, 0.f) & 0xffffu); }
DEV float sigm(float x) { return __builtin_amdgcn_rcpf(1.f + __expf(-x)); }
DEV float gelu_tanh(float x) { float u = 0.7978845608028654f * (x + 0.044715f * x * x * x); return x * sigm(2.f * u); }
DEV int acc_row(int reg, int lane) { return (reg & 3) + 8 * (reg >> 2) + 4 * (lane >> 5); }
DEV int chunk_row(int b, int q) { return q < 2 ? NLAT + b * CTX + q * 128 : b * SEQ + (q - 2) * 128; }
DEV int mod_of_row(int r) { return r < NLAT ? (r >> 11) : 8; }
DEV float wave_sum(float v) {
#pragma unroll
    for (int o = 32; o > 0; o >>= 1) v += __shfl_xor(v, o);
    return v;
}
DEV float wave_scan_add(float v, int lane) {
#pragma unroll
    for (int o = 1; o < 64; o <<= 1) { const float t = __shfl_up(v, o); if (lane >= o) v += t; }
    return v;
}
DEV float wave_scan_max(float v, int lane) {
#pragma unroll
    for (int o = 1; o < 64; o <<= 1) { const float t = __shfl_up(v, o); if (lane >= o) v = fmaxf(v, t); }
    return v;
}
DEV float wave_max(float v) {
#pragma unroll
    for (int o = 32; o > 0; o >>= 1) v = fmaxf(v, __shfl_xor(v, o));
    return v;
}
DEV f32x16 mfma(bf16x8 a, bf16x8 b, f32x16 c) { return __builtin_amdgcn_mfma_f32_32x32x16_bf16(a, b, c, 0, 0, 0); }

template <int NT> DEV void wave_mma_lds(f32x16 (&acc)[NT], const bf16_t* As, int sa, const bf16_t* Bs, int sb, int K, int lane) {
    const bf16_t* ap = As + (lane & 31) * sa + (lane >> 5) * 8;
    const bf16_t* bp = Bs + (lane & 31) * sb + (lane >> 5) * 8;
#pragma unroll 2
    for (int k = 0; k < K; k += 16) {
        bf16x8 a = *(const bf16x8*)(ap + k);
#pragma unroll
        for (int n = 0; n < NT; n++) { bf16x8 b = *(const bf16x8*)(bp + n * 32 * sb + k); acc[n] = mfma(a, b, acc[n]); }
    }
}
template <int NT, int KS> DEV void wave_mma_reg(f32x16 (&acc)[NT], const bf16x8 (&af)[KS], const bf16_t* Bs, int sb, int lane) {
    const bf16_t* bp = Bs + (lane & 31) * sb + (lane >> 5) * 8;
#pragma unroll
    for (int ks = 0; ks < KS; ks++) {
#pragma unroll
        for (int n = 0; n < NT; n++) { bf16x8 b = *(const bf16x8*)(bp + n * 32 * sb + ks * 16); acc[n] = mfma(af[ks], b, acc[n]); }
        __builtin_amdgcn_sched_barrier(0);
    }
}
template <int NC> DEV void load_tile(bf16_t* dst, int S, const bf16_t* src, size_t ld) {
    constexpr int CPR = NC / 8;
    for (int c = TID(); c < 128 * CPR; c += 256) { int r = c / CPR, kc = c % CPR; *(uint4*)(dst + r * S + kc * 8) = *(const uint4*)(src + (size_t)r * ld + kc * 8); }
}
template <int ND> DEV void load_tile_T(bf16_t* dst, int S, const bf16_t* src, size_t ld, const float* tokscale) {
    constexpr int DC = ND / 8;
    for (int c = TID(); c < 64 * DC; c += 256) {
        int tp = c & 63, dc = c >> 6;
        uint4 v0 = *(const uint4*)(src + (size_t)(2 * tp) * ld + dc * 8), v1 = *(const uint4*)(src + (size_t)(2 * tp + 1) * ld + dc * 8);
        unsigned w0[4] = {v0.x, v0.y, v0.z, v0.w}, w1[4] = {v1.x, v1.y, v1.z, v1.w};
        float s0 = 1.f, s1 = 1.f;
        if (tokscale) { s0 = tokscale[2 * tp]; s1 = tokscale[2 * tp + 1]; }
#pragma unroll
        for (int j = 0; j < 8; j++) {
            unsigned e0 = (w0[j >> 1] >> (16 * (j & 1))) & 0xffffu, e1 = (w1[j >> 1] >> (16 * (j & 1))) & 0xffffu;
            unsigned o;
            if (tokscale) o = pack2(bf2f(e0) * s0, bf2f(e1) * s1); else o = e0 | (e1 << 16);
            *(unsigned*)(dst + (dc * 8 + j) * S + 2 * tp) = o;
        }
    }
}

template <int ND> DEV void load_tile_TP(bf16_t* dst, int S, const bf16_t* src, size_t ld) {
    constexpr int DC = ND / 8;
    for (int c = TID(); c < 64 * DC; c += 256) {
        const int tp = c & 63, dc = c >> 6, l = tp & 31, g = tp >> 5, t0 = l + 64 * g, t1 = t0 + 32;
        uint4 v0 = *(const uint4*)(src + (size_t)t0 * ld + dc * 8), v1 = *(const uint4*)(src + (size_t)t1 * ld + dc * 8);
        unsigned w0[4] = {v0.x, v0.y, v0.z, v0.w}, w1[4] = {v1.x, v1.y, v1.z, v1.w};
#pragma unroll
        for (int j = 0; j < 8; j++) {
            unsigned e0 = (w0[j >> 1] >> (16 * (j & 1))) & 0xffffu, e1 = (w1[j >> 1] >> (16 * (j & 1))) & 0xffffu;
            *(unsigned*)(dst + (dc * 8 + j) * S + 4 * l + 2 * g) = e0 | (e1 << 16);
        }
    }
}

constexpr int GS = 72;
template <int NI> DEV void k_compute(f32x16 (&acc)[2][NI], const bf16_t* cA, const bf16_t* cB, int fa, int fb) {
    __builtin_amdgcn_s_setprio(1);
#pragma unroll
    for (int ks = 0; ks < 4; ks++) {
        bf16x8 a0 = *(const bf16x8*)(cA + fa + ks * 16), a1 = *(const bf16x8*)(cA + fa + 32 * GS + ks * 16);
#pragma unroll
        for (int ni = 0; ni < NI; ni++) {
            bf16x8 b0 = *(const bf16x8*)(cB + fb + ni * 32 * GS + ks * 16);
            acc[0][ni] = mfma(b0, a0, acc[0][ni]); acc[1][ni] = mfma(b0, a1, acc[1][ni]);
        }
    }
    __builtin_amdgcn_s_setprio(0);
}
typedef unsigned u32x4 __attribute__((ext_vector_type(4)));
struct RegSet { u32x4 a0, a1, a2, a3, b0, b1, b2, b3; };
template <int NI> DEV void rs_load(RegSet& r, const bf16_t* a, const bf16_t* b, int lda, int ldb) {
    r.a0 = *(const u32x4*)(a); r.a1 = *(const u32x4*)(a + (size_t)32 * lda); r.a2 = *(const u32x4*)(a + (size_t)64 * lda); r.a3 = *(const u32x4*)(a + (size_t)96 * lda);
    r.b0 = *(const u32x4*)(b); r.b1 = *(const u32x4*)(b + (size_t)32 * ldb);
    if (NI == 2) { r.b2 = *(const u32x4*)(b + (size_t)64 * ldb); r.b3 = *(const u32x4*)(b + (size_t)96 * ldb); }
}
template <int NI> DEV void rs_store(const RegSet& r, bf16_t* sa, bf16_t* sb) {
    *(u32x4*)(sa) = r.a0; *(u32x4*)(sa + 32 * GS) = r.a1; *(u32x4*)(sa + 64 * GS) = r.a2; *(u32x4*)(sa + 96 * GS) = r.a3;
    *(u32x4*)(sb) = r.b0; *(u32x4*)(sb + 32 * GS) = r.b1;
    if (NI == 2) { *(u32x4*)(sb + 64 * GS) = r.b2; *(u32x4*)(sb + 96 * GS) = r.b3; }
}
template <int NI, int NK = 0> DEV void gemm_kloop(f32x16 (&acc)[2][NI], const bf16_t* __restrict__ A, int lda, const bf16_t* __restrict__ B, int ldb, int K, bf16_t* lds,
                                      const bf16_t* nA, const bf16_t* nB, int nlda, int nldb, bool first, RegSet& p, RegSet& q) {
    const int tid = TID(), lane = tid & 63, wave = tid >> 6, wr = wave >> 1, wc = wave & 1;
    bf16_t* sA = lds;
    bf16_t* sB = lds + 2 * 128 * GS;
    const int lrow = tid >> 3, lkc = (tid & 7) * 8;
    const bf16_t* ga = A + (size_t)lrow * lda + lkc;
    const bf16_t* gb = B + (size_t)lrow * ldb + lkc;
    const bool hasn = nA != nullptr;
    const bf16_t* na = hasn ? nA + (size_t)lrow * nlda + lkc : ga;
    const bf16_t* nb = hasn ? nB + (size_t)lrow * nldb + lkc : gb;
    const int so = lrow * GS + lkc;
    const int nk = NK > 0 ? NK : (K >> 6);
    const int fa = (wr * 64 + (lane & 31)) * GS + (lane >> 5) * 8;
    const int fb = (wc * 32 * NI + (lane & 31)) * GS + (lane >> 5) * 8;
    if (first) {
        rs_load<NI>(p, ga, gb, lda, ldb);
        rs_store<NI>(p, sA + so, sB + so);
        rs_load<NI>(p, ga + 64, gb + 64, lda, ldb);
        rs_load<NI>(q, ga + 128, gb + 128, lda, ldb);
        __syncthreads();
    }
#pragma unroll (NK > 0 ? NK / 2 : 1)
    for (int kt = 0; kt < nk; kt += 2) {
        k_compute<NI>(acc, sA, sB, fa, fb);
        rs_store<NI>(p, sA + 128 * GS + so, sB + 128 * GS + so);
        if (kt + 3 < nk) rs_load<NI>(p, ga + (size_t)(kt + 3) * 64, gb + (size_t)(kt + 3) * 64, lda, ldb);
        else if (hasn) rs_load<NI>(p, na + (size_t)(kt + 3 - nk) * 64, nb + (size_t)(kt + 3 - nk) * 64, nlda, nldb);
        __syncthreads();
        k_compute<NI>(acc, sA + 128 * GS, sB + 128 * GS, fa, fb);
        if (kt + 2 < nk || hasn) rs_store<NI>(q, sA + so, sB + so);
        if (kt + 4 < nk) rs_load<NI>(q, ga + (size_t)(kt + 4) * 64, gb + (size_t)(kt + 4) * 64, lda, ldb);
        else if (hasn) rs_load<NI>(q, na + (size_t)(kt + 4 - nk) * 64, nb + (size_t)(kt + 4 - nk) * 64, nlda, nldb);
        __syncthreads();
    }
}
DEV void tile_of(int t, int mtiles, int ntiles, int& mt, int& nt) {
    const int nig = 32 * ntiles, gid = t / nig, fm = gid * 32, gsz = min(mtiles - fm, 32);
    mt = fm + (t % nig) % gsz; nt = (t % nig) / gsz;
}
template <int NI> DEV void zero_acc(f32x16 (&acc)[2][NI]) {
#pragma unroll
    for (int i = 0; i < 2; i++)
#pragma unroll
        for (int j = 0; j < NI; j++)
#pragma unroll
            for (int r = 0; r < 16; r++) acc[i][j][r] = 0.f;
}

DEV void wconv_job(const Params& p, int l, int job, bf16_t* lds) {
    bf16_t* W = (bf16_t*)(p.ws + WS_W);
    const int tid = TID();
    int mat, sub = 0, K, ntl;
    bf16_t* dst;
    if (job < 2816) { mat = 0; sub = job / 1408; job %= 1408; K = 1024; dst = W + (size_t)sub * 5632 * 1024; }
    else if (job < 4224) { job -= 2816; mat = 1; sub = job / 704; job %= 704; K = 2816; dst = W + NW13 + (size_t)sub * 1024 * 2816; }
    else if (job < 5984) { job -= 4224; mat = 2; K = 1024; dst = W + NW13 + NW2; }
    else if (job < 6368) { job -= 5984; mat = 3; sub = job / 128; job %= 128; K = 512; dst = W + NW13 + NW2 + NWIN + (size_t)sub * 1024 * 512; }
    else { job -= 6368; mat = 4; K = 1024; dst = W + NW13 + NW2 + NWIN + NWB; }
    const int ktl = K / 64;
    ntl = job / ktl; const int kt = job % ktl;
    const int n0 = ntl * 64, k0 = kt * 64;
    const int nn = tid & 63, np = n0 + nn;
    const float* colp = nullptr; size_t ld = 0;
    if (mat == 0) { int g = np >> 6, s = (np >> 5) & 1, j = np & 31; colp = (s ? p.w3 : p.w1) + ((size_t)(l * 2 + sub) * 1024) * DFF + g * 32 + j; ld = DFF; }
    else if (mat == 1) { colp = p.w2 + ((size_t)(l * 2 + sub) * DFF) * 1024 + np; ld = 1024; }
    else if (mat == 2) { int oc = np < 3072 ? np : (np < 6912 ? np + 16 : (np < 6928 ? np - 6912 + 3072 : -1)); if (oc >= 0) colp = p.w_in + (size_t)l * 1024 * DIN + oc; ld = DIN; }
    else if (mat == 3) { colp = p.w_branch + ((size_t)(l * 3 + sub) * 512) * 1024 + np; ld = 1024; }
    else { colp = p.w_out + (size_t)l * 1024 * 1024 + np; ld = 1024; }
    bf16_t* tl = lds;
#pragma unroll 4
    for (int it = 0; it < 8; it++) {
        const int kk = 2 * ((tid >> 6) + 4 * it);
        const float v0 = colp ? colp[(size_t)(k0 + kk) * ld] : 0.f, v1 = colp ? colp[(size_t)(k0 + kk + 1) * ld] : 0.f;
#ifdef NW
        *(unsigned*)(tl + nn * 66 + kk) = pack2(v0, v1) & 0xfffefffeu;
#else
        *(unsigned*)(tl + nn * 66 + kk) = pack2(v0, v1);
#endif
    }
    __syncthreads();
#pragma unroll
    for (int it = 0; it < 2; it++) {
        int ch = tid + 256 * it, r = ch >> 3, kc = ch & 7;
        const unsigned* s = (const unsigned*)(tl + r * 66 + kc * 8);
        uint4 v; v.x = s[0]; v.y = s[1]; v.z = s[2]; v.w = s[3];
        *(uint4*)(dst + (size_t)(n0 + r) * K + k0 + kc * 8) = v;
    }
    __syncthreads();
}
constexpr int NWJOBS = 6624;

DEV void ada_job(const Params& p, int job, float* lds) {
    const int tid = TID();
    const int l = job / 144, n0 = (job % 144) * 64;
    float* sc = lds;
    float* red = lds + 9 * 1024;
    __syncthreads();
    for (int i = tid; i < 9 * 1024; i += 256) { float v = i < 8192 ? p.c[i] : p.c_ctx[i - 8192]; sc[i] = v * sigm(v); }
    __syncthreads();
    const int cg = tid & 15, kg = tid >> 4;
    const float* w = p.ada_w + ((size_t)l * 1024 + kg * 64) * NMODC + n0 + cg * 4;
    float4 a[9];
#pragma unroll
    for (int m = 0; m < 9; m++) a[m] = make_float4(0.f, 0.f, 0.f, 0.f);
#pragma unroll 8
    for (int k = 0; k < 64; k++) {
        const float4 wv = *(const float4*)(w + (size_t)k * NMODC);
#pragma unroll
        for (int m = 0; m < 9; m++) { const float sv = sc[m * 1024 + kg * 64 + k]; a[m].x += sv * wv.x; a[m].y += sv * wv.y; a[m].z += sv * wv.z; a[m].w += sv * wv.w; }
    }
#pragma unroll
    for (int m = 0; m < 9; m++) *(float4*)(red + (kg * 9 + m) * 64 + cg * 4) = a[m];
    __syncthreads();
    float* mod = (float*)(p.ws + WS_MOD);
    for (int i = tid; i < 9 * 64; i += 256) {
        const int m = i >> 6, cc = i & 63;
        float sum = 0.f;
#pragma unroll
        for (int g = 0; g < 16; g++) sum += red[(g * 9 + m) * 64 + cc];
        mod[((size_t)l * 9 + m) * NMODC + n0 + cc] = sum + p.ada_b[(size_t)l * NMODC + n0 + cc];
    }
    __syncthreads();
}

DEV void norm_phase(const Params& p, int l, int which, int nrows) {
    const float* X = (const float*)(p.ws + WS_X);
    bf16_t* XN = (bf16_t*)(p.ws + WS_XN);
    const float* mod = (const float*)(p.ws + WS_MOD) + (size_t)l * 9 * NMODC;
    const float* g = p.norm_g + ((size_t)l * 3 + which) * D;
    const int lane = TID() & 63, gw = blockIdx.x * 4 + (TID() >> 6), nw = gridDim.x * 4;
    for (int r = gw; r < nrows; r += nw) {
        const float4* xr = (const float4*)(X + (size_t)r * D);
        float4 v[4]; float ss = 0.f;
#pragma unroll
        for (int i = 0; i < 4; i++) { v[i] = xr[2 * lane + (i & 1) + 128 * (i >> 1)]; ss += v[i].x * v[i].x + v[i].y * v[i].y + v[i].z * v[i].z + v[i].w * v[i].w; }
        ss = wave_sum(ss);
        const float rstd = rsqrtf(ss * (1.f / D) + EPS);
        const float* mrow = mod + (size_t)mod_of_row(r) * NMODC;
#pragma unroll
        for (int h = 0; h < 2; h++) {
            unsigned w[4];
#pragma unroll
            for (int q = 0; q < 2; q++) {
                const int i = 2 * h + q, c = 8 * lane + 4 * q + 512 * h;
                const float4 gg = *(const float4*)(g + c), sh = *(const float4*)(mrow + (3 * which) * D + c), sc = *(const float4*)(mrow + (3 * which + 1) * D + c);
                const float y0 = v[i].x * rstd * gg.x * (1.f + sc.x) + sh.x, y1 = v[i].y * rstd * gg.y * (1.f + sc.y) + sh.y;
                const float y2 = v[i].z * rstd * gg.z * (1.f + sc.z) + sh.z, y3 = v[i].w * rstd * gg.w * (1.f + sc.w) + sh.w;
                w[2 * q] = pack2(y0, y1); w[2 * q + 1] = pack2(y2, y3);
            }
            uint4 o; o.x = w[0]; o.y = w[1]; o.z = w[2]; o.w = w[3];
            *(uint4*)(XN + (size_t)r * D + 8 * lane + 512 * h) = o;
        }
    }
}

DEV void ffn_up_phase(const Params& p, int f, int mtiles, bf16_t* lds) {
    const bf16_t* A = (const bf16_t*)(p.ws + WS_XN);
    const bf16_t* Bt = (const bf16_t*)(p.ws + WS_W) + (size_t)f * 5632 * 1024;
    bf16_t* U = (bf16_t*)(p.ws + WS_U);
    const int tid = TID(), lane = tid & 63, wave = tid >> 6, wr = wave >> 1, wc = wave & 1;
    const int ntiles = 44, tot = mtiles * ntiles;
    RegSet rp = {}, rq = {}; bool first = true;
    for (int t = blockIdx.x; t < tot; t += gridDim.x) {
        int mt, nt; tile_of(t, mtiles, ntiles, mt, nt);
        const bool hasn = t + (int)gridDim.x < tot; int mt2 = 0, nt2 = 0; if (hasn) tile_of(t + gridDim.x, mtiles, ntiles, mt2, nt2);
        f32x16 acc[2][2]; zero_acc<2>(acc);
        gemm_kloop<2, 16>(acc, A + (size_t)mt * 128 * D, D, Bt + (size_t)nt * 128 * D, D, D, lds, hasn ? A + (size_t)mt2 * 128 * D : nullptr, hasn ? Bt + (size_t)nt2 * 128 * D : nullptr, D, D, first, rp, rq);
        first = false;
        const int hh = lane >> 5;
#pragma unroll
        for (int mi = 0; mi < 2; mi++) {
            const int row = mt * 128 + wr * 64 + mi * 32 + (lane & 31);
#pragma unroll
            for (int gp = 0; gp < 2; gp++) {
                unsigned pk[2][2];
#pragma unroll
                for (int gg = 0; gg < 2; gg++) {
                    const int g = 2 * gp + gg;
                    float u[4];
#pragma unroll
                    for (int j = 0; j < 4; j++) { const float h1 = acc[mi][0][4 * g + j], h3 = acc[mi][1][4 * g + j]; u[j] = h1 * sigm(h1) * h3; }
                    pk[gg][0] = pack2(u[0], u[1]); pk[gg][1] = pack2(u[2], u[3]);
                }
                const unsigned s0 = hh ? pk[0][0] : pk[1][0], s1 = hh ? pk[0][1] : pk[1][1];
                const unsigned r0 = (unsigned)__shfl_xor((int)s0, 32), r1 = (unsigned)__shfl_xor((int)s1, 32);
                uint4 o;
                if (hh == 0) { o.x = pk[0][0]; o.y = pk[0][1]; o.z = r0; o.w = r1; }
                else { o.x = r0; o.y = r1; o.z = pk[1][0]; o.w = pk[1][1]; }
                const int ucol = nt * 64 + wc * 32 + 16 * gp + 8 * hh;
                *(uint4*)(U + (size_t)row * DFF + ucol) = o;
            }
        }
    }
}
template <int NK> DEV void resid_gemm_phase(const Params& p, int l, const bf16_t* A, int K, const bf16_t* Bt, int gidx, float scale, int mtiles, bf16_t* lds, float* outp = nullptr) {
    float* X = (float*)(p.ws + WS_X);
    const float* mod = (const float*)(p.ws + WS_MOD) + (size_t)l * 9 * NMODC;
    const int tid = TID(), lane = tid & 63, wave = tid >> 6, wr = wave >> 1, wc = wave & 1;
    const int ntiles = 8, tot = mtiles * ntiles, G = gridDim.x;
    const int tfull = (tot / G) * G;
    {
        RegSet rp = {}, rq = {}; bool first = true;
        for (int t = blockIdx.x; t < tfull; t += G) {
            int mt, nt; tile_of(t, mtiles, ntiles, mt, nt);
            const bool hasn = t + G < tfull; int mt2 = 0, nt2 = 0; if (hasn) tile_of(t + G, mtiles, ntiles, mt2, nt2);
            f32x16 acc[2][2]; zero_acc<2>(acc);
            gemm_kloop<2, NK>(acc, A + (size_t)mt * 128 * K, K, Bt + (size_t)nt * 128 * K, K, K, lds, hasn ? A + (size_t)mt2 * 128 * K : nullptr, hasn ? Bt + (size_t)nt2 * 128 * K : nullptr, K, K, first, rp, rq);
            first = false;
            const float* mrow = mod + (size_t)mod_of_row(mt * 128) * NMODC + gidx * D;
#pragma unroll
            for (int ni = 0; ni < 2; ni++)
#pragma unroll
                for (int g = 0; g < 4; g++) {
                    const int col = nt * 128 + wc * 64 + ni * 32 + 8 * g + 4 * (lane >> 5);
                    const float4 gt = *(const float4*)(mrow + col);
#pragma unroll
                    for (int mi = 0; mi < 2; mi++) {
                        const int row = mt * 128 + wr * 64 + mi * 32 + (lane & 31);
                        float4* xp = (float4*)(X + (size_t)row * D + col);
                        float4 xv = *xp;
                        xv.x += scale * gt.x * acc[mi][ni][4 * g + 0]; xv.y += scale * gt.y * acc[mi][ni][4 * g + 1];
                        xv.z += scale * gt.z * acc[mi][ni][4 * g + 2]; xv.w += scale * gt.w * acc[mi][ni][4 * g + 3];
                        if (outp) *(float4*)(outp + (size_t)row * D + col) = xv; else *xp = xv;
                    }
                }
        }
    }
    {
        const int nhalf = 2 * (tot - tfull);
        RegSet rp = {}, rq = {};
        for (int h = blockIdx.x; h < nhalf; h += G) {
            int mt, nt; tile_of(tfull + (h >> 1), mtiles, ntiles, mt, nt);
            const int nt2 = nt * 2 + (h & 1);
            f32x16 acc[2][1]; zero_acc<1>(acc);
            gemm_kloop<1, NK>(acc, A + (size_t)mt * 128 * K, K, Bt + (size_t)nt2 * 64 * K, K, K, lds, nullptr, nullptr, K, K, true, rp, rq);
            const float* mrow = mod + (size_t)mod_of_row(mt * 128) * NMODC + gidx * D;
#pragma unroll
            for (int g = 0; g < 4; g++) {
                const int col = nt2 * 64 + wc * 32 + 8 * g + 4 * (lane >> 5);
                const float4 gt = *(const float4*)(mrow + col);
#pragma unroll
                for (int mi = 0; mi < 2; mi++) {
                    const int row = mt * 128 + wr * 64 + mi * 32 + (lane & 31);
                    float4* xp = (float4*)(X + (size_t)row * D + col);
                    float4 xv = *xp;
                    xv.x += scale * gt.x * acc[mi][0][4 * g + 0]; xv.y += scale * gt.y * acc[mi][0][4 * g + 1];
                    xv.z += scale * gt.z * acc[mi][0][4 * g + 2]; xv.w += scale * gt.w * acc[mi][0][4 * g + 3];
                    if (outp) *(float4*)(outp + (size_t)row * D + col) = xv; else *xp = xv;
                }
            }
        }
    }
}
DEV void win_tile_of(int t, bool last, int& mt, int& nt) {
    if (!last) { tile_of(t, 144, 55, mt, nt); return; }
    if (t < 128 * 55) { tile_of(t, 128, 55, mt, nt); return; }
    const int u = t - 128 * 55, k = u >> 4;
    mt = 128 + (u & 15);
    nt = k < 4 ? k : (k < 12 ? 8 + k : (k < 14 ? 16 + k : 54));
}
DEV void win_phase(const Params& p, bool last, bf16_t* lds) {
    const bf16_t* A = (const bf16_t*)(p.ws + WS_XN);
    const bf16_t* Bt = (const bf16_t*)(p.ws + WS_W) + NW13 + NW2;
    bf16_t* P = (bf16_t*)(p.ws + WS_P);
    float* G = (float*)(p.ws + WS_G);
    const int tid = TID(), lane = tid & 63, wave = tid >> 6, wr = wave >> 1, wc = wave & 1;
    const int tot = last ? 128 * 55 + 16 * 15 : 144 * 55;
    RegSet rp = {}, rq = {}; bool first = true;
    for (int t = blockIdx.x; t < tot; t += gridDim.x) {
        int mt, nt; win_tile_of(t, last, mt, nt);
        const bool hasn = t + (int)gridDim.x < tot; int mt2 = 0, nt2 = 0; if (hasn) win_tile_of(t + gridDim.x, last, mt2, nt2);
        f32x16 acc[2][2]; zero_acc<2>(acc);
        gemm_kloop<2, 16>(acc, A + (size_t)mt * 128 * D, D, Bt + (size_t)nt * 128 * D, D, D, lds, hasn ? A + (size_t)mt2 * 128 * D : nullptr, hasn ? Bt + (size_t)nt2 * 128 * D : nullptr, D, D, first, rp, rq);
        first = false;
        if (nt < 54) {
            const int hh = lane >> 5;
#pragma unroll
            for (int ni = 0; ni < 2; ni++)
#pragma unroll
                for (int mi = 0; mi < 2; mi++) {
                    const int row = mt * 128 + wr * 64 + mi * 32 + (lane & 31);
#pragma unroll
                    for (int gp = 0; gp < 2; gp++) {
                        const int g0 = 2 * gp, g1 = g0 + 1;
                        const unsigned a0 = pack2(acc[mi][ni][4 * g0], acc[mi][ni][4 * g0 + 1]), a1 = pack2(acc[mi][ni][4 * g0 + 2], acc[mi][ni][4 * g0 + 3]);
                        const unsigned b0 = pack2(acc[mi][ni][4 * g1], acc[mi][ni][4 * g1 + 1]), b1 = pack2(acc[mi][ni][4 * g1 + 2], acc[mi][ni][4 * g1 + 3]);
                        const unsigned s0 = hh ? a0 : b0, s1 = hh ? a1 : b1;
                        const unsigned r0 = (unsigned)__shfl_xor((int)s0, 32), r1 = (unsigned)__shfl_xor((int)s1, 32);
                        uint4 o;
                        if (hh == 0) { o.x = a0; o.y = a1; o.z = r0; o.w = r1; }
                        else { o.x = r0; o.y = r1; o.z = b0; o.w = b1; }
                        const int col = nt * 128 + wc * 64 + ni * 32 + 16 * gp + 8 * hh;
                        *(uint4*)(P + (size_t)row * PW + col) = o;
                    }
                }
        } else {
#pragma unroll
        for (int ni = 0; ni < 2; ni++)
#pragma unroll
            for (int g = 0; g < 4; g++) {
                const int col = nt * 128 + wc * 64 + ni * 32 + 8 * g + 4 * (lane >> 5);
#pragma unroll
                for (int mi = 0; mi < 2; mi++) {
                    const int row = mt * 128 + wr * 64 + mi * 32 + (lane & 31);
                    if (col < PW) { uint2 o; o.x = pack2(acc[mi][ni][4 * g], acc[mi][ni][4 * g + 1]); o.y = pack2(acc[mi][ni][4 * g + 2], acc[mi][ni][4 * g + 3]); *(uint2*)(P + (size_t)row * PW + col) = o; }
                    else if (col < PW + 16) *(float4*)(G + (size_t)row * 16 + (col - PW)) = make_float4(acc[mi][ni][4 * g], acc[mi][ni][4 * g + 1], acc[mi][ni][4 * g + 2], acc[mi][ni][4 * g + 3]);
                }
            }
        }
    }
}
DEV void merge_phase(const Params& p, int mtiles, bf16_t* lds) {
    const bf16_t* Y = (const bf16_t*)(p.ws + WS_Y);
    const bf16_t* Wb = (const bf16_t*)(p.ws + WS_W) + NW13 + NW2 + NWIN;
    const bf16_t* P = (const bf16_t*)(p.ws + WS_P);
    bf16_t* M = (bf16_t*)(p.ws + WS_XN);
    const int tid = TID(), lane = tid & 63, wave = tid >> 6, wr = wave >> 1, wc = wave & 1;
    const int ntiles = 16, tot = mtiles * ntiles;
    RegSet rp = {}, rq = {}; bool first = true;
    for (int t = blockIdx.x; t < tot; t += gridDim.x) {
        int mt, nt; tile_of(t, mtiles, ntiles, mt, nt);
        const bool hasn = t + (int)gridDim.x < tot; int mt2 = 0, nt2 = 0; if (hasn) tile_of(t + gridDim.x, mtiles, ntiles, mt2, nt2);
        f32x16 out[2][1]; zero_acc<1>(out);
#pragma unroll 1
        for (int j = 0; j < 3; j++) {
            f32x16 acc[2][1]; zero_acc<1>(acc);
            const int jn = j < 2 ? j + 1 : 0, mtn = j < 2 ? mt : mt2, ntn = j < 2 ? nt : nt2;
            const bool hn = j < 2 || hasn;
            gemm_kloop<1, 8>(acc, Y + (size_t)j * NTOK * 512 + (size_t)mt * 128 * 512, 512, Wb + (size_t)j * 1024 * 512 + (size_t)nt * 64 * 512, 512, 512, lds,
                          hn ? Y + (size_t)jn * NTOK * 512 + (size_t)mtn * 128 * 512 : nullptr, hn ? Wb + (size_t)jn * 1024 * 512 + (size_t)ntn * 64 * 512 : nullptr, 512, 512, first, rp, rq);
            first = false;
#pragma unroll
            for (int mi = 0; mi < 2; mi++) {
                const int row = mt * 128 + wr * 64 + mi * 32 + (lane & 31);
#pragma unroll
                for (int g = 0; g < 4; g++) {
                    const int col = nt * 64 + wc * 32 + 8 * g + 4 * (lane >> 5);
                    const uint2 gv = *(const uint2*)(P + (size_t)row * PW + C_BRG + j * 1024 + col);
                    out[mi][0][4 * g + 0] += sigm(bf2f(gv.x & 0xffffu)) * acc[mi][0][4 * g + 0];
                    out[mi][0][4 * g + 1] += sigm(bf2f(gv.x >> 16)) * acc[mi][0][4 * g + 1];
                    out[mi][0][4 * g + 2] += sigm(bf2f(gv.y & 0xffffu)) * acc[mi][0][4 * g + 2];
                    out[mi][0][4 * g + 3] += sigm(bf2f(gv.y >> 16)) * acc[mi][0][4 * g + 3];
                }
            }
        }
#pragma unroll
        for (int mi = 0; mi < 2; mi++) {
            const int row = mt * 128 + wr * 64 + mi * 32 + (lane & 31);
#pragma unroll
            for (int g = 0; g < 4; g++) {
                const int col = nt * 64 + wc * 32 + 8 * g + 4 * (lane >> 5);
                uint2 o; o.x = pack2(out[mi][0][4 * g], out[mi][0][4 * g + 1]); o.y = pack2(out[mi][0][4 * g + 2], out[mi][0][4 * g + 3]);
                *(uint2*)(M + (size_t)row * D + col) = o;
            }
        }
    }
}

DEV void attprep_job(const Params& p, int l, int job) {
    const bf16_t* P = (const bf16_t*)(p.ws + WS_P);
    bf16_t* Qa = (bf16_t*)(p.ws + WS_QA);
    bf16_t* Ka = (bf16_t*)(p.ws + WS_KA);
    const int lane = TID() & 63, wave = TID() >> 6;
    const float gq = p.qn_g[l * 64 + lane], gk = p.kn_g[l * 64 + lane];
    const float inv = exp2f(-(float)(lane & 15) * (13.287712379549449f / 16.f));
    for (int i = 0; i < 8; i++) {
        const int r = job * 32 + wave * 8 + i;
        float cs = 1.f, sn = 0.f;
        if (r < NLAT) { const int tk = r & (SEQ - 1); const float pos = (lane < 32) ? (float)(tk >> 6) : (float)(tk & 63); const float ang = pos * inv; cs = __cosf(ang); sn = __sinf(ang); }
        const float sgn = (lane & 16) ? 1.f : -1.f;
        for (int hd = 0; hd < 10; hd++) {
            const float xv = bf2f(P[(size_t)r * PW + C_ATQ + hd * 64 + lane]);
            const float ss = wave_sum(xv * xv);
            float y = xv * rsqrtf(ss * (1.f / 64.f) + EPS) * (hd < 8 ? gq : gk);
            const float yp = __shfl_xor(y, 16);
            y = y * cs + sgn * yp * sn;
#ifdef NAT
            if (hd < 8) Qa[(size_t)r * 512 + hd * 64 + lane] = f2bf(y * 0.125f) & 0xfffe;
            else Ka[(size_t)r * 128 + (hd - 8) * 64 + lane] = f2bf(y) & 0xfffe;
#else
            if (hd < 8) Qa[(size_t)r * 512 + hd * 64 + lane] = f2bf(y * 0.125f);
            else Ka[(size_t)r * 128 + (hd - 8) * 64 + lane] = f2bf(y);
#endif
        }
    }
}

DEV void att_job(const Params& p, int l, int b, int qb, int h, bf16_t* lds) {
    const bf16_t* P = (const bf16_t*)(p.ws + WS_P);
    const bf16_t* Qa = (const bf16_t*)(p.ws + WS_QA);
    const bf16_t* Ka = (const bf16_t*)(p.ws + WS_KA);
    bf16_t* Yc = (bf16_t*)(p.ws + WS_Y) + (size_t)2 * NTOK * 512;
    const int tid = TID(), lane = tid & 63, wave = tid >> 6;
    bf16_t* Ks = lds;
    bf16_t* Vt = lds + 128 * 72;
    bf16_t* Pw = Vt + 64 * 136;
    const int kvh = h >> 2;
    const int Rq = qb < 16 ? b * SEQ + qb * 128 : NLAT + b * CTX + (qb - 16) * 128;
#ifdef ATT_COPY
    for (int i = tid; i < 128 * 64; i += 256) { const int r = i >> 6, c = i & 63; Yc[(size_t)(Rq + r) * 512 + h * 64 + c] = Qa[(size_t)(Rq + r) * 512 + h * 64 + c]; }
    return;
#endif
    __syncthreads();
    load_tile<64>(Pw, 72, Qa + (size_t)Rq * 512 + h * 64, 512);
    __syncthreads();
    bf16x8 qf[4];
#pragma unroll
    for (int ks = 0; ks < 4; ks++) qf[ks] = *(const bf16x8*)(Pw + (wave * 32 + (lane & 31)) * 72 + ks * 16 + (lane >> 5) * 8);
    const float sink = p.sink[l * 8 + h];
    float mrun[16], lrun[16];
    f32x16 o[2];
#pragma unroll
    for (int r = 0; r < 16; r++) { mrun[r] = sink; lrun[r] = 0.f; o[0][r] = 0.f; o[1][r] = 0.f; }
    for (int kt = 0; kt < 5; kt++) {
        int Rk, mode = 0;
        if (kt < 3) {
            if (qb >= 16) continue;
            const int nb = qb - 1 + kt;
            if (nb < 0 || nb >= 16) continue;
            Rk = b * SEQ + nb * 128; mode = kt == 0 ? 1 : (kt == 2 ? 2 : 0);
        } else Rk = NLAT + b * CTX + (kt - 3) * 128;
        __syncthreads();
        load_tile<64>(Ks, 72, Ka + (size_t)Rk * 128 + kvh * 64, 128);
        load_tile_TP<64>(Vt, 136, P + (size_t)Rk * PW + C_ATV + kvh * 64, PW);
        __syncthreads();
        f32x16 s[4];
#pragma unroll
        for (int n = 0; n < 4; n++)
#pragma unroll
            for (int r = 0; r < 16; r++) s[n][r] = 0.f;
        wave_mma_reg<4, 4>(s, qf, Ks, 72, lane);
#pragma unroll
        for (int r = 0; r < 16; r++) {
            const int qi = wave * 32 + acc_row(r, lane);
            float mx = -3.0e38f;
#pragma unroll
            for (int n = 0; n < 4; n++) {
                const int ki = n * 32 + (lane & 31);
#if 1
                const int dpos = (kt < 3) ? ((qb - 1 + kt) * 128 + ki) - (qb * 128 + qi) : 0;
                const bool ok = dpos <= 128 && dpos >= -128;
#else
                const bool ok = mode == 0 || (mode == 1 ? ki >= qi : ki <= qi);
#endif
                const float v = ok ? s[n][r] : -1e30f;
                s[n][r] = v; mx = fmaxf(mx, v);
            }
#pragma unroll
            for (int off = 16; off > 0; off >>= 1) mx = fmaxf(mx, __shfl_xor(mx, off));
            const float mnew = fmaxf(mrun[r], mx);
            const float alpha = __expf(mrun[r] - mnew);
            mrun[r] = mnew;
            float ps = 0.f, pv[4];
#pragma unroll
            for (int n = 0; n < 4; n++) { pv[n] = __expf(s[n][r] - mnew); ps += pv[n]; }
            { uint2 w; w.x = pack2(pv[0], pv[1]); w.y = pack2(pv[2], pv[3]);
#ifdef NAT
              w.x &= 0xfffefffeu; w.y &= 0xfffefffeu;
#endif
              *(uint2*)(Pw + (wave * 32 + acc_row(r, lane)) * 136 + 4 * (lane & 31)) = w; }
            lrun[r] = lrun[r] * alpha + ps;
            o[0][r] *= alpha; o[1][r] *= alpha;
        }
        __syncthreads();
        wave_mma_lds<2>(o, Pw + wave * 32 * 136, 136, Vt, 136, 128, lane);
    }
#pragma unroll
    for (int r = 0; r < 16; r++) {
        float ls = lrun[r];
#pragma unroll
        for (int off = 16; off > 0; off >>= 1) ls += __shfl_xor(ls, off);
        ls += __expf(sink - mrun[r]);
        const float inv = 1.f / ls;
        const int row = Rq + wave * 32 + acc_row(r, lane);
#ifdef ATT_T1
        Yc[(size_t)row * 512 + h * 64 + (lane & 31)] = f2bf(inv);
        Yc[(size_t)row * 512 + h * 64 + 32 + (lane & 31)] = f2bf(mrun[r]);
#elif defined(ATT_T2)
        Yc[(size_t)row * 512 + h * 64 + (lane & 31)] = f2bf(o[0][r]);
        Yc[(size_t)row * 512 + h * 64 + 32 + (lane & 31)] = f2bf(o[1][r]);
#else
#ifdef ATT_ZERO_EDGE
        const float zz = (qb == 0 || qb == 15) ? 0.f : 1.f;
#elif defined(ATT_ZERO_MID)
        const float zz = (qb == 5 || qb == 10) ? 0.f : 1.f;
#else
        const float zz = 1.f;
#endif
        Yc[(size_t)row * 512 + h * 64 + (lane & 31)] = f2bf(o[0][r] * inv * zz);
        Yc[(size_t)row * 512 + h * 64 + 32 + (lane & 31)] = f2bf(o[1][r] * inv * zz);
#endif
    }
}


DEV void att_naive_job(const Params& p, int l, int job, int nrows) {
    const bf16_t* P = (const bf16_t*)(p.ws + WS_P);
    const bf16_t* Qa = (const bf16_t*)(p.ws + WS_QA);
    const bf16_t* Ka = (const bf16_t*)(p.ws + WS_KA);
    bf16_t* Yc = (bf16_t*)(p.ws + WS_Y) + (size_t)2 * NTOK * 512;
    const int gid = job * 256 + TID();
    const int R = gid >> 3, h = gid & 7, kvh = h >> 2;
    if (R >= nrows) return;
#ifdef NAIVE_CTX_ONLY
    if (R < NLAT) return;
#endif
#ifdef NAIVE_LAT_ONLY
    if (R >= NLAT) return;
#endif
    float q[64], o[64];
#pragma unroll
    for (int d = 0; d < 64; d++) { q[d] = bf2f(Qa[(size_t)R * 512 + h * 64 + d]); o[d] = 0.f; }
    float m = p.sink[l * 8 + h], lsum = 1.f;
    const bool lat = R < NLAT;
    const int b = lat ? (R >> 11) : ((R - NLAT) >> 8);
    const int t = lat ? (R & 2047) : 0;
    const int nband = lat ? 257 : 0;
    for (int kk = 0; kk < nband + 256; kk++) {
        int Rk;
        if (kk < nband) { const int tk = t - 128 + kk; if (tk < 0 || tk >= SEQ) continue; Rk = b * SEQ + tk; }
        else Rk = NLAT + b * CTX + (kk - nband);
        float sdot = 0.f;
#pragma unroll
        for (int d = 0; d < 64; d++) sdot += q[d] * bf2f(Ka[(size_t)Rk * 128 + kvh * 64 + d]);
        const float mn = fmaxf(m, sdot), al = expf(m - mn), pe = expf(sdot - mn);
        lsum = lsum * al + pe; m = mn;
#pragma unroll
        for (int d = 0; d < 64; d++) o[d] = o[d] * al + pe * bf2f(P[(size_t)Rk * PW + C_ATV + kvh * 64 + d]);
    }
    const float inv = 1.f / lsum;
#pragma unroll
    for (int d = 0; d < 64; d++) Yc[(size_t)R * 512 + h * 64 + d] = f2bf(o[d] * inv);
}
DEV void rg_coeffs(const Params& p, int l, int b, int q, int n, int dir, unsigned char* ldsb) {
    const bf16_t* P = (const bf16_t*)(p.ws + WS_P);
    const int tid = TID(), lane = tid & 63, wave = tid >> 6;
    bf16_t* u16 = (bf16_t*)ldsb;
    bf16_t* wt = u16 + 128 * 72;
    float* a32 = (float*)ldsb;
    float* ub32 = (float*)(ldsb + 36864);
    __syncthreads();
    {
        const int c8 = (tid & 7) * 8, cbase = n * 64 + c8;
        const int seqbase = q < 2 ? NLAT + b * CTX : b * SEQ, ts0 = q < 2 ? q * 128 : (q - 2) * 128, Ls = q < 2 ? CTX : SEQ;
        float cw[4][8], cb[8];
#pragma unroll
        for (int j = 0; j < 8; j++) { cb[j] = p.conv_b[l * 512 + cbase + j];
#pragma unroll
            for (int k = 0; k < 4; k++) cw[k][j] = p.conv_w[(l * 4 + k) * 512 + cbase + j]; }
        for (int ps = 0; ps < 4; ps++) {
            const int t = (tid >> 3) + 32 * ps;
            float a[8];
#pragma unroll
            for (int j = 0; j < 8; j++) a[j] = cb[j];
#pragma unroll
            for (int k = 0; k < 4; k++) {
                const int ts = ts0 + t + k - 2;
                if (ts >= 0 && ts < Ls) {
                    const uint4 v = *(const uint4*)(P + (size_t)(seqbase + ts) * PW + C_RGX + cbase);
                    const unsigned w[4] = {v.x, v.y, v.z, v.w};
#pragma unroll
                    for (int j = 0; j < 8; j++) a[j] += cw[k][j] * bf2f((w[j >> 1] >> (16 * (j & 1))) & 0xffffu);
                }
            }
            *(float4*)(ub32 + t * 64 + c8) = make_float4(a[0], a[1], a[2], a[3]);
            *(float4*)(ub32 + t * 64 + c8 + 4) = make_float4(a[4], a[5], a[6], a[7]);
            uint4 o; o.x = pack2(a[0], a[1]); o.y = pack2(a[2], a[3]); o.z = pack2(a[4], a[5]); o.w = pack2(a[6], a[7]);
#ifdef NRG
            o.x &= 0xfffefffeu; o.y &= 0xfffefffeu; o.z &= 0xfffefffeu; o.w &= 0xfffefffeu;
#endif
            *(uint4*)(u16 + t * 72 + c8) = o;
        }
        const float* wa = p.wa + (size_t)((l * 2 + dir) * 8 + n) * 4096;
        const float* wi = p.wi + (size_t)((l * 2 + dir) * 8 + n) * 4096;
        const int j = tid & 63;
#pragma unroll 4
        for (int it = 0; it < 8; it++) {
            const int i = 2 * ((tid >> 6) + 4 * it);
            *(unsigned*)(wt + j * 72 + i) = pack2(wa[i * 64 + j], wa[(i + 1) * 64 + j]);
            *(unsigned*)(wt + (64 + j) * 72 + i) = pack2(wi[i * 64 + j], wi[(i + 1) * 64 + j]);
        }
    }
    __syncthreads();
    f32x16 acc[4];
#pragma unroll
    for (int nn = 0; nn < 4; nn++)
#pragma unroll
        for (int r = 0; r < 16; r++) acc[nn][r] = 0.f;
    wave_mma_lds<4>(acc, u16 + wave * 32 * 72, 72, wt, 72, 64, lane);
    __syncthreads();
#pragma unroll
    for (int c2 = 0; c2 < 2; c2++) {
        const int ch = c2 * 32 + (lane & 31), c = n * 64 + ch;
        const float lam = p.lam[(l * 2 + dir) * 512 + c];
        const float cl = 8.f * log1pf(__expf(-lam));
        const float ba = p.ba[(l * 2 + dir) * 512 + c], bi = p.bi[(l * 2 + dir) * 512 + c];
#pragma unroll
        for (int r = 0; r < 16; r++) {
            const int t = wave * 32 + acc_row(r, lane);
            const float rr = sigm(acc[c2][r] + ba), ii = sigm(acc[2 + c2][r] + bi);
            const float la = -cl * rr;
            const float av = __expf(la);
            const float bv = sqrtf(-expm1f(2.f * la)) * ii * ub32[t * 64 + ch];
            a32[t * 64 + ch] = av;
            ub32[t * 64 + ch] = bv;
        }
    }
    __syncthreads();
}
DEV void rg_r1_job(const Params& p, int l, int item, unsigned char* ldsb) {
    const int dir = item & 1, n = (item >> 1) & 7, bq = item >> 4, q = bq % 18, b = bq / 18;
    rg_coeffs(p, l, b, q, n, dir, ldsb);
    const float* a32 = (const float*)ldsb;
    const float* b32 = (const float*)(ldsb + 36864);
    float* segP = (float*)(ldsb + 69632);
    float* segH = segP + 256;
    const int tid = TID(), ch = tid & 63, seg = tid >> 6;
    const int tseg = dir ? 3 - seg : seg;
    float Pp = 1.f, hh = 0.f;
#pragma unroll 8
    for (int i = 0; i < 32; i++) { const int t = seg * 32 + (dir ? 31 - i : i); const float a = a32[t * 64 + ch]; hh = a * hh + b32[t * 64 + ch]; Pp *= a; }
    segP[tseg * 64 + ch] = Pp; segH[tseg * 64 + ch] = hh;
    __syncthreads();
    if (seg == 0) {
        float PP = 1.f, H = 0.f;
#pragma unroll
        for (int k = 0; k < 4; k++) { H = segP[k * 64 + ch] * H + segH[k * 64 + ch]; PP *= segP[k * 64 + ch]; }
        float2* rgs = (float2*)(p.ws + WS_RGS);
        rgs[(size_t)((b * 2 + dir) * 18 + q) * 512 + n * 64 + ch] = make_float2(PP, H);
    }
}
DEV void rg_r2_job(const Params& p, int l, int b, int q, int n, unsigned char* ldsb) {
    const bf16_t* P = (const bf16_t*)(p.ws + WS_P);
    bf16_t* Ya = (bf16_t*)(p.ws + WS_Y);
    const float2* rgs = (const float2*)(p.ws + WS_RGS);
    const float* a32 = (const float*)ldsb;
    const float* b32 = (const float*)(ldsb + 36864);
    float* segP = (float*)(ldsb + 69632);
    float* segH = segP + 256;
    const int tid = TID(), ch = tid & 63, seg = tid >> 6, c = n * 64 + ch;
    const int R0 = chunk_row(b, q);
    float hf[32];
#pragma unroll
    for (int dir = 0; dir < 2; dir++) {
        rg_coeffs(p, l, b, q, n, dir, ldsb);
        const int pos = dir ? (q < 2 ? 1 - q : 19 - q) : q;
        float hc = 0.f;
        for (int k = 0; k < pos; k++) { const int qq = dir ? (k < 2 ? 1 - k : 19 - k) : k; const float2 v = rgs[(size_t)((b * 2 + dir) * 18 + qq) * 512 + c]; hc = v.x * hc + v.y; }
        const int tseg = dir ? 3 - seg : seg;
        float Pp = 1.f, hh = 0.f;
#pragma unroll 8
        for (int i = 0; i < 32; i++) { const int t = seg * 32 + (dir ? 31 - i : i); const float a = a32[t * 64 + ch]; hh = a * hh + b32[t * 64 + ch]; Pp *= a; }
        segP[tseg * 64 + ch] = Pp; segH[tseg * 64 + ch] = hh;
        __syncthreads();
        float hs = hc;
        for (int k = 0; k < tseg; k++) hs = segP[k * 64 + ch] * hs + segH[k * 64 + ch];
        if (dir == 0) {
#pragma unroll
            for (int i = 0; i < 32; i++) { const int t = seg * 32 + i; hs = a32[t * 64 + ch] * hs + b32[t * 64 + ch]; hf[i] = hs; }
        } else {
#pragma unroll
            for (int i = 0; i < 32; i++) {
                const int jj = 31 - i, t = seg * 32 + jj;
                hs = a32[t * 64 + ch] * hs + b32[t * 64 + ch];
                const float g = bf2f(P[(size_t)(R0 + t) * PW + C_RGG + c]);
#ifdef NY
                Ya[(size_t)(R0 + t) * 512 + c] = f2bf((hf[jj] + hs) * gelu_tanh(g)) & 0xfffe;
#else
                Ya[(size_t)(R0 + t) * 512 + c] = f2bf((hf[jj] + hs) * gelu_tanh(g));
#endif
            }
        }
    }
}

DEV float log_sigmoid(float x) { return fminf(x, 0.f) - log1pf(__expf(-fabsf(x))); }
DEV void ml_m1_job(const Params& p, int l, int item, bf16_t* lds) {
    const bf16_t* P = (const bf16_t*)(p.ws + WS_P);
    const float* G = (const float*)(p.ws + WS_G);
    const int tid = TID(), lane = tid & 63, wave = tid >> 6;
    const int q = item % 18, chain = item / 18, dir = chain & 1, h = (chain >> 1) & 3, b = chain >> 3;
    const int R0 = chunk_row(b, q);
    bf16_t* As = lds;
    bf16_t* Bs = lds + 128 * 136;
    float* sm = (float*)(lds + 2 * 128 * 136);
    float* ig = sm; float* fl = sm + 128; float* we = sm + 256; float* wv = sm + 384; float* misc = sm + 512;
    __syncthreads();
    if (tid < 128) {
        ig[tid] = G[(size_t)(R0 + tid) * 16 + (2 * dir) * 4 + h] + p.gate_b[l * 16 + (2 * dir) * 4 + h];
        fl[tid] = log_sigmoid(G[(size_t)(R0 + tid) * 16 + (2 * dir + 1) * 4 + h] + p.gate_b[l * 16 + (2 * dir + 1) * 4 + h]);
    }
    __syncthreads();
    if (wave == 0) {
        const int p0 = 2 * lane, s0 = dir ? 127 - p0 : p0, s1 = dir ? 126 - p0 : p0 + 1;
        const float f0 = fl[s0], f1 = fl[s1], c1 = f0 + f1;
        const float sc = wave_scan_add(c1, lane), tot = __shfl(sc, 63), off = sc - c1;
        const float w0 = tot - (off + f0) + ig[s0], w1 = tot - (off + c1) + ig[s1];
        we[s0] = w0; we[s1] = w1;
        const float mx = wave_max(fmaxf(w0, w1));
        if (lane == 0) { misc[0] = mx; misc[1] = tot; float* mls = (float*)(p.ws + WS_MLS); mls[item * 2] = mx; mls[item * 2 + 1] = tot; }
    }
    __syncthreads();
    if (tid < 128) wv[tid] = __expf(we[tid] - misc[0]);
    __syncthreads();
    load_tile_T<128>(As, 136, P + (size_t)R0 * PW + C_MLV + h * 128, PW, wv);
    load_tile_T<128>(Bs, 136, P + (size_t)R0 * PW + C_MLK + h * 128, PW, nullptr);
    __syncthreads();
    f32x16 acc[4];
#pragma unroll
    for (int n = 0; n < 4; n++)
#pragma unroll
        for (int r = 0; r < 16; r++) acc[n][r] = 0.f;
    wave_mma_lds<4>(acc, As + wave * 32 * 136, 136, Bs, 136, 128, lane);
    const float ksc = 0.08838834764831845f;
    float* dC = (float*)(p.ws + WS_DC) + (size_t)item * 16384;
#pragma unroll
    for (int n = 0; n < 4; n++)
#pragma unroll
        for (int r = 0; r < 16; r++) dC[(wave * 32 + acc_row(r, lane)) * 128 + n * 32 + (lane & 31)] = acc[n][r] * ksc;
    {
        const int dk = tid >> 1, hf = tid & 1;
        float s = 0.f;
        for (int i = 0; i < 64; i++) { const int ss = hf * 64 + i; s += bf2f(Bs[dk * 136 + ss]) * wv[ss]; }
        s += __shfl_xor(s, 1);
        if (hf == 0) ((float*)(p.ws + WS_DN))[(size_t)item * 128 + dk] = s * ksc;
    }
}
DEV void ml_m2_job(const Params& p, int item) {
    const int tid = TID(), slice = item & 15, chain = item >> 4, dir = chain & 1;
    const float* dC = (const float*)(p.ws + WS_DC);
    const float* dn = (const float*)(p.ws + WS_DN);
    const float* mls = (const float*)(p.ws + WS_MLS);
    bf16_t* Cin = (bf16_t*)(p.ws + WS_CIN);
    float* nin = (float*)(p.ws + WS_NIN);
    float* min_ = (float*)(p.ws + WS_MIN);
    const int e0 = slice * 1024 + tid * 4;
    float4 C = make_float4(0.f, 0.f, 0.f, 0.f);
    float nv = 0.f, m = 0.f;
    for (int k = 0; k < 18; k++) {
        const int q = dir ? (k < 2 ? 1 - k : 19 - k) : k;
        const int it = chain * 18 + q;
        uint2 o; o.x = pack2(C.x, C.y); o.y = pack2(C.z, C.w);
#ifdef NML
        o.x &= 0xfffefffeu; o.y &= 0xfffefffeu;
#endif
        *(uint2*)(Cin + (size_t)it * 16384 + e0) = o;
        if (slice == 0) { if (tid < 128) nin[(size_t)it * 128 + tid] = nv; if (tid == 0) min_[it] = m; }
        if (k == 17) break;
        const float mloc = mls[it * 2], bend = mls[it * 2 + 1];
        const float mnew = fmaxf(bend + m, mloc);
        const float d1 = __expf(bend + m - mnew), d2 = __expf(mloc - mnew);
        const float4 dc = *(const float4*)(dC + (size_t)it * 16384 + e0);
        C.x = d1 * C.x + d2 * dc.x; C.y = d1 * C.y + d2 * dc.y; C.z = d1 * C.z + d2 * dc.z; C.w = d1 * C.w + d2 * dc.w;
        if (slice == 0 && tid < 128) nv = d1 * nv + d2 * dn[(size_t)it * 128 + tid];
        m = mnew;
    }
}
DEV void ml_m3_job(const Params& p, int l, int b, int h, int q, bf16_t* lds) {
    const bf16_t* P = (const bf16_t*)(p.ws + WS_P);
    const float* G = (const float*)(p.ws + WS_G);
    const bf16_t* Cin = (const bf16_t*)(p.ws + WS_CIN);
    const float* nin = (const float*)(p.ws + WS_NIN);
    const float* min_ = (const float*)(p.ws + WS_MIN);
    bf16_t* Yb = (bf16_t*)(p.ws + WS_Y) + (size_t)NTOK * 512;
    const int tid = TID(), lane = tid & 63, wave = tid >> 6;
    const int R0 = chunk_row(b, q);
    bf16_t* Bs = lds;
    bf16_t* Pw = lds + 128 * 136;
    float* sm = (float*)(lds + 2 * 128 * 136);
    float* ig = sm; float* fl = sm + 128; float* acol = sm + 256; float* Mrow = sm + 384; float* brow = sm + 512; float* nl = sm + 640; float* qn = sm + 768; float* denl = sm + 896; float* decl = sm + 1024; float* bndl = sm + 1152;
    __syncthreads();
    load_tile<128>(Pw, 136, P + (size_t)R0 * PW + C_MLQ + h * 128, PW);
    __syncthreads();
    bf16x8 qf[8];
#pragma unroll
    for (int ks = 0; ks < 8; ks++) qf[ks] = *(const bf16x8*)(Pw + (wave * 32 + (lane & 31)) * 136 + ks * 16 + (lane >> 5) * 8);
    float* Ht = (float*)(p.ws + WS_XN);
    const float ksc = 0.08838834764831845f;
#pragma unroll 1
    for (int dir = 0; dir < 2; dir++) {
        const int it = ((b * 4 + h) * 2 + dir) * 18 + q;
        const float m_in = min_[it];
        __syncthreads();
        if (tid < 128) {
            ig[tid] = G[(size_t)(R0 + tid) * 16 + (2 * dir) * 4 + h] + p.gate_b[l * 16 + (2 * dir) * 4 + h];
            fl[tid] = log_sigmoid(G[(size_t)(R0 + tid) * 16 + (2 * dir + 1) * 4 + h] + p.gate_b[l * 16 + (2 * dir + 1) * 4 + h]);
            nl[tid] = nin[(size_t)it * 128 + tid];
        }
        load_tile<128>(Bs, 136, P + (size_t)R0 * PW + C_MLK + h * 128, PW);
        __syncthreads();
        if (wave == 0) {
            const int p0 = 2 * lane, s0 = dir ? 127 - p0 : p0, s1 = dir ? 126 - p0 : p0 + 1;
            const float f0 = fl[s0], f1 = fl[s1], c1 = f0 + f1;
            const float sc = wave_scan_add(c1, lane), off = sc - c1, b0 = off + f0, b1 = off + c1;
            const float a0 = ig[s0] - b0, a1 = ig[s1] - b1;
            const float sm = wave_scan_max(fmaxf(a0, a1), lane);
            float prev = __shfl_up(sm, 1); if (lane == 0) prev = -3.0e38f;
            const float pm0 = fmaxf(prev, a0);
            brow[s0] = b0; brow[s1] = b1; acol[s0] = a0; acol[s1] = a1;
            Mrow[s0] = fmaxf(m_in, pm0); Mrow[s1] = fmaxf(m_in, sm);
        }
        {
            float s = 0.f;
#pragma unroll
            for (int ks = 0; ks < 8; ks++)
#pragma unroll
                for (int j = 0; j < 8; j++) { s += bf2f((unsigned short)qf[ks][j]) * nl[ks * 16 + (lane >> 5) * 8 + j]; if (j == 7) __builtin_amdgcn_sched_barrier(0); }
            s += __shfl_xor(s, 32);
            if (lane < 32) qn[wave * 32 + lane] = s;
        }
        f32x16 s4[4];
#pragma unroll
        for (int n = 0; n < 4; n++)
#pragma unroll
            for (int r = 0; r < 16; r++) s4[n][r] = 0.f;
        wave_mma_reg<4, 8>(s4, qf, Bs, 136, lane);
        __syncthreads();
        const int lnA = OPQ(lane);
#pragma unroll
        for (int r = 0; r < 16; r++) {
            const int t = wave * 32 + acc_row(r, lnA);
            const float Mt = Mrow[t];
            float ps = 0.f, pv[4];
#pragma unroll
            for (int n = 0; n < 4; n++) {
                const int s = n * 32 + (lnA & 31);
                const bool ok = dir ? (s >= t) : (s <= t);
                pv[n] = ok ? s4[n][r] * ksc * __expf(acol[s] - Mt) : 0.f;
                ps += pv[n];
            }
            { uint2 w; w.x = pack2(pv[0], pv[1]); w.y = pack2(pv[2], pv[3]);
#ifdef NML
              w.x &= 0xfffefffeu; w.y &= 0xfffefffeu;
#endif
              *(uint2*)(Pw + t * 136 + 4 * (lnA & 31)) = w; }
#pragma unroll
            for (int off = 16; off > 0; off >>= 1) ps += __shfl_xor(ps, off);
            const float dc = __expf(m_in - Mt);
            if ((lnA & 31) == 0) { denl[t] = ps + dc * qn[t]; decl[t] = dc; bndl[t] = __expf(-(brow[t] + Mt)); }
            __builtin_amdgcn_sched_barrier(0);
        }
        load_tile<128>(Bs, 136, Cin + (size_t)it * 16384, 128);
        __syncthreads();
        f32x16 num[4];
#pragma unroll
        for (int n = 0; n < 4; n++)
#pragma unroll
            for (int r = 0; r < 16; r++) num[n][r] = 0.f;
        wave_mma_reg<4, 8>(num, qf, Bs, 136, lane);
        const int lnB = OPQ(lane);
#pragma unroll
        for (int r = 0; r < 16; r++) {
            const float dc = decl[wave * 32 + acc_row(r, lnB)];
#pragma unroll
            for (int n = 0; n < 4; n++) num[n][r] *= dc;
        }
        __syncthreads();
        load_tile_TP<128>(Bs, 136, P + (size_t)R0 * PW + C_MLV + h * 128, PW);
        __syncthreads();
        wave_mma_lds<4>(num, Pw + wave * 32 * 136, 136, Bs, 136, 128, lane);
        const int lnC = OPQ(lane);
        if (dir == 0) {
#pragma unroll
            for (int r = 0; r < 16; r++) {
                const int t = wave * 32 + acc_row(r, lnC);
                const float inv = 1.f / fmaxf(fabsf(denl[t]), bndl[t]);
#pragma unroll
                for (int n = 0; n < 4; n++) Ht[(size_t)(R0 + t) * 512 + h * 128 + n * 32 + (lnC & 31)] = num[n][r] * inv;
                __builtin_amdgcn_sched_barrier(0);
            }
        } else {
#pragma unroll
            for (int r = 0; r < 16; r++) {
                const int t = wave * 32 + acc_row(r, lnC);
                const float inv = 1.f / fmaxf(fabsf(denl[t]), bndl[t]);
                float hv[4], ss = 0.f;
#pragma unroll
                for (int n = 0; n < 4; n++) { hv[n] = num[n][r] * inv + Ht[(size_t)(R0 + t) * 512 + h * 128 + n * 32 + (lnC & 31)]; ss += hv[n] * hv[n]; }
#pragma unroll
                for (int off = 16; off > 0; off >>= 1) ss += __shfl_xor(ss, off);
                const float rstd = rsqrtf(ss * (1.f / 128.f) + EPS);
#pragma unroll
                for (int n = 0; n < 4; n++) {
                    const int cc = h * 128 + n * 32 + (lnC & 31);
                    const float og = sigm(bf2f(P[(size_t)(R0 + t) * PW + C_MLO + cc]));
#ifdef NML
                    Yb[(size_t)(R0 + t) * 512 + cc] = f2bf(hv[n] * rstd * p.ml_norm_g[l * 512 + cc] * og) & 0xfffe;
#else
                    Yb[(size_t)(R0 + t) * 512 + cc] = f2bf(hv[n] * rstd * p.ml_norm_g[l * 512 + cc] * og);
#endif
                }
                __builtin_amdgcn_sched_barrier(0);
            }
        }
    }
}

#define XB_TMO      128
#define XB_XCNT(j)  (256  + 64 * (j))
#define XB_XSUB(j)  (1280 + 64 * (j))
#define XB_XGEN(j)  (2304 + 64 * (j))
#define XB_TOP      3328
#define XB_TOPGEN   3392
#define XCD_BAR_WORDS 3456
#define XB_SPIN_CAP (1u << 22)
#define LAS __attribute__((address_space(3)))
DEV unsigned xb_ld(unsigned* p)              { return __hip_atomic_load(p, __ATOMIC_RELAXED, __HIP_MEMORY_SCOPE_AGENT); }
DEV unsigned xb_add(unsigned* p, unsigned v) { return __hip_atomic_fetch_add(p, v, __ATOMIC_RELAXED, __HIP_MEMORY_SCOPE_AGENT); }
DEV unsigned xb_xcc_id() { return (unsigned)__builtin_amdgcn_s_getreg((3 << 11) | 20) & 0xFu; }
#define XB_SPIN(cond, bar) do { unsigned _sp = 0; while (cond) { __builtin_amdgcn_s_sleep(1); \
    if ((++_sp & 255u) == 0u) { if (xb_ld(&(bar)[XB_TMO])) break; if (_sp > XB_SPIN_CAP) { atomicAdd(&(bar)[XB_TMO], 1u); break; } } } } while (0)
struct XcdBarrier { unsigned* bar; unsigned x; volatile LAS unsigned* st; };
DEV XcdBarrier xcd_barrier_post(unsigned* bar, volatile LAS unsigned* st) {
    XcdBarrier b; b.bar = bar; b.x = xb_xcc_id(); b.st = st;
    if (threadIdx.x == 0) (void)xb_add(&bar[XB_XCNT(b.x)], 1u);
    return b;
}
DEV void xcd_barrier_complete(unsigned* bar, unsigned x, unsigned& nloc, unsigned& nx) {
    const unsigned G = gridDim.x * gridDim.y * gridDim.z;
    unsigned sum, cnt, mine, sp = 0u;
    for (;;) {
        sum = 0u; cnt = 0u; mine = 0u;
#pragma unroll
        for (unsigned j = 0; j < 16; ++j) { const unsigned c = xb_ld(&bar[XB_XCNT(j)]); sum += c; cnt += (c > 0u) ? 1u : 0u; mine = (j == x) ? c : mine; }
        if (sum == G) break;
        __builtin_amdgcn_s_sleep(1);
        if ((++sp & 255u) == 0u) { if (xb_ld(&bar[XB_TMO])) break; if (sp > XB_SPIN_CAP) { atomicAdd(&bar[XB_TMO], 1u); break; } }
    }
    nloc = mine > 0u ? mine : 1u; nx = cnt > 0u ? cnt : 1u;
}
DEV void xcd_barrier(const XcdBarrier& b) {
    asm volatile("s_waitcnt vmcnt(0)" ::: "memory");
    __syncthreads();
    if (threadIdx.x == 0) {
        unsigned* bar = b.bar;
        __builtin_amdgcn_s_waitcnt(0);
        unsigned nloc = b.st[0], nx = b.st[1];
        if (nloc == 0u) { xcd_barrier_complete(bar, b.x, nloc, nx); b.st[0] = nloc; b.st[1] = nx; }
        const unsigned old = xb_add(&bar[XB_XSUB(b.x)], 1u);
        const unsigned gen = old / nloc;
        if (old + 1u == (gen + 1u) * nloc) {
            __builtin_amdgcn_fence(__ATOMIC_RELEASE, "agent");
            asm volatile("s_waitcnt vmcnt(0)" ::: "memory");
            const unsigned og = xb_add(&bar[XB_TOP], 1u);
            const unsigned tg = og / nx;
            if (og + 1u == (tg + 1u) * nx) xb_add(&bar[XB_TOPGEN], 1u);
            else XB_SPIN(xb_ld(&bar[XB_TOPGEN]) == tg, bar);
            __builtin_amdgcn_fence(__ATOMIC_ACQUIRE, "agent");
            xb_add(&bar[XB_XGEN(b.x)], 1u);
            asm volatile("s_waitcnt vmcnt(0)" ::: "memory");
        } else {
            XB_SPIN(xb_ld(&bar[XB_XGEN(b.x)]) == gen, bar);
            __builtin_amdgcn_fence(__ATOMIC_ACQUIRE, "agent");
            asm volatile("s_waitcnt vmcnt(0)" ::: "memory");
        }
    }
    __syncthreads();
}
DEV int next_job(unsigned* ctr, volatile unsigned* slot) {
    __syncthreads();
    if (threadIdx.x == 0) *slot = __hip_atomic_fetch_add(ctr, 1u, __ATOMIC_RELAXED, __HIP_MEMORY_SCOPE_AGENT);
    __syncthreads();
    return __builtin_amdgcn_readfirstlane((int)*slot);
}
__global__ void __launch_bounds__(256, 2) fwd_megakernel(Params p) {
    cg::grid_group grid = cg::this_grid();
    extern __shared__ __attribute__((aligned(16))) unsigned char ldsb[];
    bf16_t* lds = (bf16_t*)ldsb;
    const int G_ = gridDim.x, bid = blockIdx.x, tid = threadIdx.x;
    unsigned* bar = (unsigned*)(p.ws + WS_BAR);
    volatile LAS unsigned* xst = (volatile LAS unsigned*)(LAS unsigned char*)(ldsb + LDS_BYTES - 16);
    volatile unsigned* jslot = (volatile unsigned*)(ldsb + LDS_BYTES - 8);
    if (tid == 0) { xst[0] = 0u; xst[1] = 0u; }
    __syncthreads();
    const XcdBarrier xb = xcd_barrier_post(bar, xst);
    if (p.ws == nullptr) grid.sync();
#ifdef REP_BAR
#define GS() do { xcd_barrier(xb); xcd_barrier(xb); } while (0)
#else
#define GS() xcd_barrier(xb)
#endif

    {
        for (int j = bid; j < 576 + NWJOBS; j += G_) { if (j < 576) { PH(1) ada_job(p, j, (float*)ldsb); } else { PH(1) wconv_job(p, 0, j - 576, lds); } }
        float4* X4 = (float4*)(p.ws + WS_X);
        const float4* x4 = (const float4*)p.x; const float4* c4 = (const float4*)p.ctx;
        const size_t nl4 = (size_t)NLAT * D / 4, nt4 = (size_t)NTOK * D / 4;
        for (size_t i = (size_t)bid * 256 + tid; i < nt4; i += (size_t)G_ * 256) X4[i] = i < nl4 ? x4[i] : c4[i - nl4];
    }
    GS();
    const bf16_t* W = (const bf16_t*)(p.ws + WS_W);
    for (int l = 0; l < DEPTH; l++) {
        const bool ctx_out = l < DEPTH - 1;
        const int mt_all = 144, mt_late = ctx_out ? 144 : 128;
        if (l > 0) { for (int rep = 0; rep < REP_NORM; rep++) for (int j = bid; j < NWJOBS; j += G_) wconv_job(p, l, j, lds); }
        for (int rep = 0; rep < REP_NORM; rep++) { PH(2) norm_phase(p, l, 0, NTOK); }
        GS();
        for (int rep = 0; rep < REP_GEMM; rep++) { PH(4) ffn_up_phase(p, 0, mt_all, lds); }
        GS();
        PH(8) resid_gemm_phase<44>(p, l, (const bf16_t*)(p.ws + WS_U), DFF, W + NW13, 2, 0.5f, mt_all, lds);
        GS();
#ifndef SKIP_MIX
        for (int rep = 0; rep < REP_NORM; rep++) norm_phase(p, l, 1, NTOK);
        GS();
        for (int rep = 0; rep < REP_GEMM; rep++) { PH(16) win_phase(p, !ctx_out, lds); }
        GS();
        for (int rep = 0; rep < REP_MIX1; rep++)
        for (int j = bid; j < 1152 + 2304 + 576; j += G_) {
            if (j < 1152) { MX(1) ml_m1_job(p, l, j, lds); }
            else if (j < 3456) { MX(2) rg_r1_job(p, l, j - 1152, ldsb); }
            else { MX(4) attprep_job(p, l, j - 3456); }
        }
        GS();
        {
            const int q0 = ctx_out ? 0 : 2, nq = 18 - q0;
            const int natt = NB * (ctx_out ? 18 : 16) * 8, nr2 = NB * nq * 8;
            for (int rep = 0; rep < REP_MIX2; rep++)
            for (int j = next_job(bar + (l * 4 + 1) * 8, jslot); j < 1024 + natt; j = next_job(bar + (l * 4 + 1) * 8, jslot)) {
                if (j < 1024) { MX(1) ml_m2_job(p, j); }
                else { int i = j - 1024; const int h = i & 7; i >>= 3; const int nqb = ctx_out ? 18 : 16; MX(4) att_job(p, l, i / nqb, i % nqb, h, lds); }
            }
            GS();
#ifdef ATT_NAIVE
            { const int nrows = ctx_out ? NTOK : NLAT; for (int j = bid; j < (nrows * 8 + 255) / 256; j += G_) att_naive_job(p, l, j, nrows); }
#endif
            for (int rep = 0; rep < REP_MIX3; rep++)
            for (int j = next_job(bar + (l * 4 + 2) * 8, jslot); j < NB * 4 * nq + nr2; j = next_job(bar + (l * 4 + 2) * 8, jslot)) {
                if (j < NB * 4 * nq) { const int q = q0 + j % nq, bh = j / nq; MX(1) ml_m3_job(p, l, bh >> 2, bh & 3, q, lds); }
                else { int i = j - NB * 4 * nq; const int n = i & 7; i >>= 3; MX(2) rg_r2_job(p, l, i / nq, q0 + i % nq, n, ldsb); }
            }
        }
        GS();
        for (int rep = 0; rep < REP_GEMM; rep++) { PH(4096) merge_phase(p, mt_late, lds); }
        GS();
        resid_gemm_phase<16>(p, l, (const bf16_t*)(p.ws + WS_XN), D, W + NW13 + NW2 + NWIN + NWB, 5, 1.0f, mt_late, lds);
        GS();
#endif
        for (int rep = 0; rep < REP_NORM; rep++) norm_phase(p, l, 2, mt_late * 128);
        GS();
        for (int rep = 0; rep < REP_GEMM; rep++) ffn_up_phase(p, 1, mt_late, lds);
        GS();
        resid_gemm_phase<44>(p, l, (const bf16_t*)(p.ws + WS_U), DFF, W + NW13 + NW2 / 2, 8, 0.5f, mt_late, lds, ctx_out ? nullptr : p.out);
        if (ctx_out) GS();
    }
}

extern "C" void kernel_launch(void* const* d_in, const int* in_sizes, int n_in, void* d_out, int out_size, void* d_ws, size_t ws_size, hipStream_t stream) {
    static int grid_blocks = 0;
    if (!grid_blocks) {
        int dev = 0, cus = 0, per_cu = 0;
        hipGetDevice(&dev);
        hipDeviceGetAttribute(&cus, hipDeviceAttributeMultiprocessorCount, dev);
        hipFuncSetAttribute((const void*)fwd_megakernel, hipFuncAttributeMaxDynamicSharedMemorySize, LDS_BYTES);
        hipOccupancyMaxActiveBlocksPerMultiprocessor(&per_cu, fwd_megakernel, 256, LDS_BYTES);
        if (per_cu < 1) per_cu = 1;
        if (per_cu > 2) per_cu = 2;
        grid_blocks = cus * per_cu;
        if (ws_size < WS_END) fprintf(stderr, "workspace too small: %zu < %zu\n", ws_size, (size_t)WS_END);
    }
    Params p{};
    const float** f = (const float**)&p;
    for (int i = 0; i < 25; i++) f[i] = (const float*)d_in[i];
    p.out = (float*)d_out;
    p.ws = (unsigned char*)d_ws;
    hipMemsetAsync((char*)d_ws + WS_BAR, 0, 13824, stream);
    void* args[] = {&p};
    hipError_t e = hipLaunchCooperativeKernel((void*)fwd_megakernel, dim3(grid_blocks), dim3(256), args, LDS_BYTES, stream);
    if (e != hipSuccess) fprintf(stderr, "cooperative launch failed: %s (grid %d)\n", hipGetErrorString(e), grid_blocks);
}
```
